# Optimizing an MI355X kernel written in HIP

```python
import math
import jax, jax.numpy as jnp
from jax import lax
import numpy as np

D_MODEL = 1024
BATCH = 32
SEQ = 256
DEPTH = 4
DEC_BATCH = 4
DEC_SEQ = 2048
PAST_LEN = 256

GRID_W = 64
HEAD_DIM = 64
N_HEADS = D_MODEL // HEAD_DIM
N_KV_HEADS = N_HEADS // 4
Q_BLOCK = 128
ROPE_THETA = 10000.0
CONV_W = D_MODEL // 2
CONV_K = 3
SSM_W = D_MODEL // 2
SSM_GROUP_CH = 16
SSM_GROUPS = SSM_W // SSM_GROUP_CH
SSM_STATE = 64
N_DIR = 2
D_FF = -(-8 * D_MODEL // (3 * 256)) * 256
RMS_EPS = 1e-6
IN_SIZES = (CONV_W, CONV_W, CONV_W, N_HEADS * HEAD_DIM, N_KV_HEADS * HEAD_DIM,
            N_KV_HEADS * HEAD_DIM, SSM_W, D_MODEL, D_MODEL, D_MODEL)
IN_COLS = sum(IN_SIZES)
IN_SPLITS = tuple(int(s) for s in np.cumsum(IN_SIZES)[:-1])

kernel_name = 'hybrid_diffusion_parallel_trunk_step'


def rms_norm(x, g):
    xf = x.astype(jnp.float32)
    y = xf * lax.rsqrt(jnp.mean(xf * xf, axis=-1, keepdims=True) + RMS_EPS)
    return (y * g.astype(jnp.float32)).astype(x.dtype)


def rope_axis(x, pos):
    f = x.shape[-1] // 2
    inv = ROPE_THETA ** (-jnp.arange(f, dtype=jnp.float32) / f)
    ang = pos.astype(jnp.float32)[:, None] * inv[None, :]
    cos = jnp.cos(ang)[None, :, None, :]
    sin = jnp.sin(ang)[None, :, None, :]
    xf = x.astype(jnp.float32)
    x1, x2 = xf[..., :f], xf[..., f:]
    return jnp.concatenate([x1 * cos - x2 * sin, x1 * sin + x2 * cos], axis=-1).astype(x.dtype)


def rope_2d(x):
    length = x.shape[1]
    rows = length // GRID_W
    row = jnp.repeat(jnp.arange(rows), GRID_W)
    col = jnp.tile(jnp.arange(GRID_W), rows)
    half = HEAD_DIM // 2
    return jnp.concatenate([rope_axis(x[..., :half], row), rope_axis(x[..., half:], col)], axis=-1)


def depthwise_conv3(x, w, b):
    y = lax.conv_general_dilated(x, w[:, None, :].astype(x.dtype), window_strides=(1,),
                                 padding=((1, 1),), dimension_numbers=('NWC', 'WIO', 'NWC'),
                                 feature_group_count=x.shape[-1])
    return y + b.astype(x.dtype)


def block_attention(q, k, v):
    bsz, lq, _, _ = q.shape
    rep = N_HEADS // N_KV_HEADS
    nb = lq // Q_BLOCK
    qb = (q * (HEAD_DIM ** -0.5)).reshape(bsz, nb, Q_BLOCK, N_KV_HEADS, rep, HEAD_DIM)
    qb = qb.transpose(1, 0, 2, 3, 4, 5)

    def one_block(qi):
        s = jnp.einsum('bqkrd,bskd->bkrqs', qi, k).astype(jnp.float32)
        p = jax.nn.softmax(s, axis=-1).astype(v.dtype)
        return jnp.einsum('bkrqs,bskd->bqkrd', p, v)

    o = lax.map(one_block, qb)
    return o.transpose(1, 0, 2, 3, 4, 5).reshape(bsz, lq, N_HEADS * HEAD_DIM)


def _complex_affine_combine(e1, e2):
    a1r, a1i, b1r, b1i = e1
    a2r, a2i, b2r, b2i = e2
    return (a2r * a1r - a2i * a1i,
            a2r * a1i + a2i * a1r,
            a2r * b1r - a2i * b1i + b2r,
            a2r * b1i + a2i * b1r + b2i)


def ssm_direction(u, h0_re, h0_im, lam_re, lam_im, b_re, b_im, c_re, c_im, log_dt):
    f32 = jnp.float32
    lam_re = lam_re.astype(f32)
    lam_im = lam_im.astype(f32)
    dt = jnp.exp(log_dt.astype(f32))[:, None]
    mag = jnp.exp(lam_re * dt)
    a_re = mag * jnp.cos(lam_im * dt)
    a_im = mag * jnp.sin(lam_im * dt)
    den = lam_re * lam_re + lam_im * lam_im
    n_re = a_re - 1.0
    coef_re = (n_re * lam_re + a_im * lam_im) / den
    coef_im = (a_im * lam_re - n_re * lam_im) / den
    b_re = b_re.astype(f32)
    b_im = b_im.astype(f32)
    bb_re = coef_re[..., None] * b_re - coef_im[..., None] * b_im
    bb_im = coef_re[..., None] * b_im + coef_im[..., None] * b_re
    x_re = jnp.einsum('blgc,gpc->blgp', u, bb_re)
    x_im = jnp.einsum('blgc,gpc->blgp', u, bb_im)
    h0_re = h0_re.astype(f32)
    h0_im = h0_im.astype(f32)
    x_re = x_re.at[:, 0].add(a_re * h0_re - a_im * h0_im)
    x_im = x_im.at[:, 0].add(a_re * h0_im + a_im * h0_re)
    ar = jnp.broadcast_to(a_re, x_re.shape)
    ai = jnp.broadcast_to(a_im, x_im.shape)
    _, _, h_re, h_im = lax.associative_scan(_complex_affine_combine, (ar, ai, x_re, x_im), axis=1)
    y = (jnp.einsum('gcp,blgp->blgc', c_re.astype(f32), h_re)
         - jnp.einsum('gcp,blgp->blgc', c_im.astype(f32), h_im))
    return y, h_re[:, -1], h_im[:, -1]


def _dir_params(p, d):
    return (p['ssm_lambda_re'][d], p['ssm_lambda_im'][d], p['ssm_b_re'][d], p['ssm_b_im'][d],
            p['ssm_c_re'][d], p['ssm_c_im'][d], p['ssm_log_dt'][d])


def ssm_branch(u, h0_re, h0_im, p):
    bsz, length, _ = u.shape
    uf = u.astype(jnp.float32)
    ug = uf.reshape(bsz, length, SSM_GROUPS, SSM_GROUP_CH)
    y_f, hf_re, hf_im = ssm_direction(ug, h0_re[:, 0], h0_im[:, 0], *_dir_params(p, 0))
    y_b, hb_re, hb_im = ssm_direction(ug[:, ::-1], h0_re[:, 1], h0_im[:, 1], *_dir_params(p, 1))
    y = (y_f + y_b[:, ::-1]).reshape(bsz, length, SSM_W) + p['ssm_d'].astype(jnp.float32) * uf
    y = jax.nn.gelu(y)
    y = y * jax.nn.sigmoid(y @ p['w_glu'].astype(jnp.float32) + p['b_glu'].astype(jnp.float32))
    return y.astype(u.dtype), jnp.stack([hf_re, hb_re], axis=1), jnp.stack([hf_im, hb_im], axis=1)


def trunk_layer(x, mod, p, ctx=None):
    bsz, length, _ = x.shape
    shift1, scale1, gate1, shift2, scale2, gate2 = jnp.split(mod, 6, axis=-1)
    h = rms_norm(x, p['norm1_g']) * (1 + scale1) + shift1
    z = h @ p['w_in']
    cb, cc, cx, q, k, v, u, g_conv, g_attn, g_ssm = jnp.split(z, IN_SPLITS, axis=-1)
    y_conv = cb * depthwise_conv3(cc * cx, p['conv_w'], p['conv_b'])
    q = rms_norm(q.reshape(bsz, length, N_HEADS, HEAD_DIM), p['q_norm_g'])
    k = rms_norm(k.reshape(bsz, length, N_KV_HEADS, HEAD_DIM), p['k_norm_g'])
    v = v.reshape(bsz, length, N_KV_HEADS, HEAD_DIM)
    if ctx is None:
        k_att, v_att = k, v
        h0_re = jnp.zeros((bsz, N_DIR, SSM_GROUPS, SSM_STATE), jnp.float32)
        h0_im = jnp.zeros((bsz, N_DIR, SSM_GROUPS, SSM_STATE), jnp.float32)
    else:
        k_ctx, v_ctx, h0_re, h0_im = ctx
        q = rope_2d(q)
        k_att = jnp.concatenate([rope_2d(k), k_ctx.astype(k.dtype)], axis=1)
        v_att = jnp.concatenate([v, v_ctx.astype(v.dtype)], axis=1)
    y_attn = block_attention(q, k_att, v_att)
    y_ssm, hT_re, hT_im = ssm_branch(u, h0_re, h0_im, p)
    merged = (jax.nn.sigmoid(g_conv) * (y_conv @ p['w_proj_conv'])
              + jax.nn.sigmoid(g_attn) * (y_attn @ p['w_proj_attn'])
              + jax.nn.sigmoid(g_ssm) * (y_ssm @ p['w_proj_ssm']))
    x = x + gate1 * (merged @ p['w_out'])
    h = rms_norm(x, p['norm2_g']) * (1 + scale2) + shift2
    x = x + gate2 * ((jax.nn.silu(h @ p['w_ffn_gate']) * (h @ p['w_ffn_up'])) @ p['w_ffn_down'])
    if ctx is None:
        return x, (k, v, hT_re, hT_im)
    return x, None


def setup_inputs(seed: int = 0) -> dict:
    key = jax.random.key(seed)
    keys = iter(jax.random.split(key, 48))
    f32 = jnp.float32

    def nrm(shape, scale):
        return jax.random.normal(next(keys), shape, f32) * scale

    ssm_shape = (DEPTH, N_DIR, SSM_GROUPS, SSM_STATE)
    n_idx = jnp.arange(SSM_STATE, dtype=f32)
    return {
        'x_prompt': nrm((BATCH, SEQ, D_MODEL), 1.0),
        'x_sample': nrm((DEC_BATCH, DEC_SEQ, D_MODEL), 1.0),
        'c': nrm((DEC_BATCH, D_MODEL), 1.0),
        'cache_k': nrm((DEC_BATCH, DEPTH, PAST_LEN, N_KV_HEADS, HEAD_DIM), 1.0),
        'cache_v': nrm((DEC_BATCH, DEPTH, PAST_LEN, N_KV_HEADS, HEAD_DIM), 1.0),
        'state_ssm_re': nrm((DEC_BATCH, DEPTH, N_DIR, SSM_GROUPS, SSM_STATE), 0.5),
        'state_ssm_im': nrm((DEC_BATCH, DEPTH, N_DIR, SSM_GROUPS, SSM_STATE), 0.5),
        'c_ctx': nrm((D_MODEL,), 1.0),
        'w_ada': nrm((DEPTH, D_MODEL, 6 * D_MODEL), D_MODEL ** -0.5),
        'b_ada': nrm((DEPTH, 6 * D_MODEL), 0.02),
        'norm1_g': 1.0 + nrm((DEPTH, D_MODEL), 0.02),
        'w_in': nrm((DEPTH, D_MODEL, IN_COLS), D_MODEL ** -0.5),
        'conv_w': nrm((DEPTH, CONV_K, CONV_W), CONV_K ** -0.5),
        'conv_b': nrm((DEPTH, CONV_W), 0.02),
        'q_norm_g': 1.0 + nrm((DEPTH, HEAD_DIM), 0.02),
        'k_norm_g': 1.0 + nrm((DEPTH, HEAD_DIM), 0.02),
        'ssm_lambda_re': -0.5 + nrm(ssm_shape, 0.01),
        'ssm_lambda_im': math.pi * n_idx + nrm(ssm_shape, 0.01),
        'ssm_b_re': nrm(ssm_shape + (SSM_GROUP_CH,), (2 * SSM_GROUP_CH) ** -0.5),
        'ssm_b_im': nrm(ssm_shape + (SSM_GROUP_CH,), (2 * SSM_GROUP_CH) ** -0.5),
        'ssm_c_re': nrm((DEPTH, N_DIR, SSM_GROUPS, SSM_GROUP_CH, SSM_STATE), (2 * SSM_STATE) ** -0.5),
        'ssm_c_im': nrm((DEPTH, N_DIR, SSM_GROUPS, SSM_GROUP_CH, SSM_STATE), (2 * SSM_STATE) ** -0.5),
        'ssm_log_dt': jax.random.uniform(next(keys), (DEPTH, N_DIR, SSM_GROUPS), f32,
                                         math.log(1e-3), math.log(1e-1)),
        'ssm_d': nrm((DEPTH, SSM_W), 1.0),
        'w_glu': nrm((DEPTH, SSM_W, SSM_W), SSM_W ** -0.5),
        'b_glu': nrm((DEPTH, SSM_W), 0.02),
        'w_proj_conv': nrm((DEPTH, CONV_W, D_MODEL), CONV_W ** -0.5),
        'w_proj_attn': nrm((DEPTH, N_HEADS * HEAD_DIM, D_MODEL), (N_HEADS * HEAD_DIM) ** -0.5),
        'w_proj_ssm': nrm((DEPTH, SSM_W, D_MODEL), SSM_W ** -0.5),
        'w_out': nrm((DEPTH, D_MODEL, D_MODEL), D_MODEL ** -0.5),
        'norm2_g': 1.0 + nrm((DEPTH, D_MODEL), 0.02),
        'w_ffn_gate': nrm((DEPTH, D_MODEL, D_FF), D_MODEL ** -0.5),
        'w_ffn_up': nrm((DEPTH, D_MODEL, D_FF), D_MODEL ** -0.5),
        'w_ffn_down': nrm((DEPTH, D_FF, D_MODEL), D_FF ** -0.5),
        'final_norm_g': 1.0 + nrm((D_MODEL,), 0.02),
    }


def reference(x_prompt, x_sample, c, cache_k, cache_v, state_ssm_re, state_ssm_im, c_ctx,
              w_ada, b_ada, norm1_g, w_in, conv_w, conv_b, q_norm_g, k_norm_g,
              ssm_lambda_re, ssm_lambda_im, ssm_b_re, ssm_b_im, ssm_c_re, ssm_c_im,
              ssm_log_dt, ssm_d, w_glu, b_glu, w_proj_conv, w_proj_attn, w_proj_ssm,
              w_out, norm2_g, w_ffn_gate, w_ffn_up, w_ffn_down, final_norm_g):
    def layer_params(l):
        return {
            'norm1_g': norm1_g[l], 'w_in': w_in[l], 'conv_w': conv_w[l], 'conv_b': conv_b[l],
            'q_norm_g': q_norm_g[l], 'k_norm_g': k_norm_g[l],
            'ssm_lambda_re': ssm_lambda_re[l], 'ssm_lambda_im': ssm_lambda_im[l],
            'ssm_b_re': ssm_b_re[l], 'ssm_b_im': ssm_b_im[l],
            'ssm_c_re': ssm_c_re[l], 'ssm_c_im': ssm_c_im[l],
            'ssm_log_dt': ssm_log_dt[l], 'ssm_d': ssm_d[l], 'w_glu': w_glu[l], 'b_glu': b_glu[l],
            'w_proj_conv': w_proj_conv[l], 'w_proj_attn': w_proj_attn[l],
            'w_proj_ssm': w_proj_ssm[l], 'w_out': w_out[l], 'norm2_g': norm2_g[l],
            'w_ffn_gate': w_ffn_gate[l], 'w_ffn_up': w_ffn_up[l], 'w_ffn_down': w_ffn_down[l],
        }

    xp = x_prompt
    ks, vs, srs, sis = [], [], [], []
    for l in range(DEPTH):
        mod_ctx = (jax.nn.silu(c_ctx) @ w_ada[l] + b_ada[l])[None, None, :]
        xp, (k_l, v_l, sr_l, si_l) = trunk_layer(xp, mod_ctx, layer_params(l), None)
        ks.append(k_l)
        vs.append(v_l)
        srs.append(sr_l)
        sis.append(si_l)
    y_prompt = rms_norm(xp, final_norm_g)
    new_cache_k = jnp.stack(ks, axis=1)
    new_cache_v = jnp.stack(vs, axis=1)
    new_state_ssm_re = jnp.stack(srs, axis=1)
    new_state_ssm_im = jnp.stack(sis, axis=1)

    xs = x_sample
    for l in range(DEPTH):
        mod_lat = (jax.nn.silu(c) @ w_ada[l] + b_ada[l])[:, None, :]
        ctx = (cache_k[:, l], cache_v[:, l], state_ssm_re[:, l], state_ssm_im[:, l])
        xs, _ = trunk_layer(xs, mod_lat, layer_params(l), ctx)
    y_sample = rms_norm(xs, final_norm_g)

    return (y_prompt, y_sample, new_cache_k, new_cache_v, new_state_ssm_re, new_state_ssm_im)
```

```cpp
#include <hip/hip_runtime.h>
#include <hip/hip_cooperative_groups.h>
#include <cstdint>
#include <cstdio>
namespace cg = cooperative_groups;

#define LAS __attribute__((address_space(3)))
typedef unsigned short bf16_t;
typedef short bf16x8 __attribute__((ext_vector_type(8)));
typedef short s16x4 __attribute__((ext_vector_type(4)));
typedef float f32x4 __attribute__((ext_vector_type(4)));
typedef float f32x2 __attribute__((ext_vector_type(2)));
typedef float f32x16 __attribute__((ext_vector_type(16)));
typedef unsigned u32x4 __attribute__((ext_vector_type(4)));
typedef unsigned u32x2 __attribute__((ext_vector_type(2)));

constexpr int MROWS = 16384, DM = 1024, INC = 6656, FF = 2816, NL = 4;
constexpr int PROMPT_ROWS = 8192;
constexpr float RMS_EPS = 1e-6f;
constexpr float QSCALE = 0.125f * 1.4426950408889634f;
constexpr size_t OUT_CK = 16777216, OUT_CV = 25165824, OUT_SR = 33554432, OUT_SI = 34078720;
constexpr size_t OFF_WIN = 0;
constexpr size_t OFF_WPROJ = OFF_WIN + (size_t)NL * INC * 1024 * 2;
constexpr size_t OFF_WOUT = OFF_WPROJ + (size_t)NL * 4 * 1024 * 512 * 2;
constexpr size_t OFF_WGLU = OFF_WOUT + (size_t)NL * 1024 * 1024 * 2;
constexpr size_t OFF_WGU = OFF_WGLU + (size_t)NL * 512 * 512 * 2;
constexpr size_t OFF_WDN = OFF_WGU + (size_t)NL * 5632 * 1024 * 2;
constexpr size_t OFF_MODP = OFF_WDN + (size_t)NL * 1024 * FF * 2;
constexpr size_t OFF_MOD = OFF_MODP + (size_t)16 * NL * 5 * 6144 * 4;
constexpr size_t OFF_SSA = OFF_MOD + (size_t)NL * 5 * 6144 * 4;
constexpr size_t OFF_BBF = OFF_SSA + (size_t)256 * 64 * 8;
constexpr size_t OFF_CCF = OFF_BBF + (size_t)256 * 8 * 1024;
constexpr size_t OFF_PW = OFF_CCF + (size_t)256 * 4 * 1024;
constexpr size_t OFF_TF = OFF_PW + (size_t)256 * 17 * 64 * 8;
constexpr size_t OFF_BBR = OFF_TF + (size_t)256 * 16 * 1024;
constexpr size_t OFF_PW16 = OFF_BBR + (size_t)256 * 64 * 16 * 8;
constexpr size_t OFF_ROPE = OFF_PW16 + (size_t)256 * 16 * 64 * 8;
constexpr size_t OFF_KC = OFF_ROPE + 8192;
constexpr size_t OFF_VC = OFF_KC + (size_t)4 * 4 * 256 * 256 * 2;
constexpr size_t OFF_H = OFF_VC + (size_t)4 * 4 * 256 * 256 * 2;
constexpr size_t OFF_CB = OFF_H + (size_t)MROWS * 1024 * 2;
constexpr size_t OFF_PCX = OFF_CB + (size_t)MROWS * 512 * 2;
constexpr size_t OFF_Q = OFF_PCX + (size_t)MROWS * 512 * 2;
constexpr size_t OFF_K = OFF_Q + (size_t)MROWS * 1024 * 2;
constexpr size_t OFF_V = OFF_K + (size_t)MROWS * 256 * 2;
constexpr size_t OFF_U = OFF_V + (size_t)MROWS * 256 * 2;
constexpr size_t OFF_G = OFF_U + (size_t)MROWS * 512 * 2;
constexpr size_t OFF_YA = OFF_G + (size_t)3 * MROWS * 1024 * 2;
constexpr size_t OFF_YG = OFF_YA + (size_t)MROWS * 1024 * 2;
constexpr size_t OFF_CTL = OFF_YG + (size_t)MROWS * 512 * 2;
constexpr size_t WS_END = OFF_CTL + 16384;

constexpr int LDS_BYTES = 131072 + 4096;

struct KArgs { const float* in[35]; float* out; unsigned char* ws; };

typedef __bf16 bf16x2_t __attribute__((ext_vector_type(2)));
__device__ __forceinline__ unsigned cvt_pk_bf16(float lo, float hi) { const f32x2 v = {lo, hi}; const bf16x2_t b = __builtin_convertvector(v, bf16x2_t); return __builtin_bit_cast(unsigned, b); }
__device__ __forceinline__ float bflo(unsigned w) { return __uint_as_float(w << 16); }
__device__ __forceinline__ float bfhi(unsigned w) { return __uint_as_float(w & 0xffff0000u); }
__device__ __forceinline__ float fsigmoid(float x) { return __builtin_amdgcn_rcpf(1.0f + __expf(-x)); }
__device__ __forceinline__ int opaque_tid() { int t = threadIdx.x; asm volatile("" : "+v"(t)); return t; }
__device__ __forceinline__ int opaque_bid() { int b = blockIdx.x; asm volatile("" : "+s"(b)); return b; }
__device__ __forceinline__ float wave_sum(float v) {
#pragma unroll
    for (int o = 1; o < 64; o <<= 1) v += __shfl_xor(v, o);
    return v;
}
__device__ __forceinline__ u32x4 pack8(f32x4 a, f32x4 b) { u32x4 w; w.x = cvt_pk_bf16(a[0], a[1]); w.y = cvt_pk_bf16(a[2], a[3]); w.z = cvt_pk_bf16(b[0], b[1]); w.w = cvt_pk_bf16(b[2], b[3]); return w; }
__device__ __forceinline__ void dsincos(double x, double& s, double& c) {
    const double k = __builtin_rint(x * 0.63661977236758134308);
    const double r = (x - k * 1.57079632679489655800) - k * 6.12323399573676603587e-17;
    const double r2 = r * r;
    double sp = -1.0 / 1307674368000.0; sp = sp * r2 + 1.0 / 6227020800.0; sp = sp * r2 - 1.0 / 39916800.0; sp = sp * r2 + 1.0 / 362880.0; sp = sp * r2 - 1.0 / 5040.0; sp = sp * r2 + 1.0 / 120.0; sp = sp * r2 - 1.0 / 6.0; sp = sp * r2 + 1.0; sp *= r;
    double cp = 1.0 / 20922789888000.0; cp = cp * r2 - 1.0 / 87178291200.0; cp = cp * r2 + 1.0 / 479001600.0; cp = cp * r2 - 1.0 / 3628800.0; cp = cp * r2 + 1.0 / 40320.0; cp = cp * r2 - 1.0 / 720.0; cp = cp * r2 + 1.0 / 24.0; cp = cp * r2 - 0.5; cp = cp * r2 + 1.0;
    const int q = ((int)k) & 3;
    s = (q == 0) ? sp : (q == 1) ? cp : (q == 2) ? -sp : -cp;
    c = (q == 0) ? cp : (q == 1) ? -sp : (q == 2) ? -cp : sp;
}

namespace pg8 {
constexpr int BM = 256, BK = 64, HALF = 128, HTB = HALF * BK * 2, NXCD = 8, WGM = 8;
__device__ __forceinline__ int lds_byte(int r, int c) { const int st = (r >> 4) * 2 + (c >> 5), rr = r & 15, cc = c & 31, ob = rr * 64 + cc * 2; return st * 1024 + (ob ^ (((ob >> 9) & 1) << 5)); }
__device__ __forceinline__ void stage_rc(int b, int& R, int& C) { const int st = b / 1024, sb = b % 1024, swz = sb ^ (((sb >> 9) & 1) << 5); R = (st >> 1) * 16 + swz / 64; C = (st & 1) * 32 + (swz % 64) / 2; }

struct Unit { int pm, pn, seg; const char* A; const char* B; };
struct TileOrder {
    int nM, nN, nwg, G, c;
    __device__ void init(int M, int N, int G_, int c_) { nM = M / BM; nN = N / BM; nwg = nM * nN; G = G_; c = c_; }
    __device__ bool tile(long L, int& pm, int& pn) const {
        if (L >= nwg) return false;
        int wgid = (int)L; { const int q = nwg / NXCD, r = nwg % NXCD, xcd = wgid % NXCD, off = wgid / NXCD; wgid = (xcd < r ? xcd * (q + 1) : r * (q + 1) + (xcd - r) * q) + off; }
        const int nig = WGM * nN, gid = wgid / nig, fm = gid * WGM, gsz = (nM - fm) < WGM ? (nM - fm) : WGM;
        pm = fm + ((wgid % nig) % gsz); pn = (wgid % nig) / gsz; return true;
    }
};
struct SchedSimple {
    TileOrder o; const char* A; const char* B; size_t tstep;
    __device__ void init(const void* A_, const void* B_, int M, int N, int K, int G, int c) { o.init(M, N, G, c); A = (const char*)A_; B = (const char*)B_; tstep = (size_t)BM * K * 2; }
    __device__ bool next(int i, Unit& u) const { int pm, pn; if (!o.tile((long)i * o.G + o.c, pm, pn)) return false; u.pm = pm; u.pn = pn; u.seg = 0; u.A = A + (size_t)pm * tstep; u.B = B + (size_t)pn * tstep; return true; }
};
struct SchedProj {
    TileOrder o; const char *A0, *A1, *A2, *A3; const char* B; size_t tstep;
    __device__ bool next(int i, Unit& u) const { int pm, pn; if (!o.tile((long)(i >> 2) * o.G + o.c, pm, pn)) return false; const int seg = i & 3; u.pm = pm; u.pn = pn; u.seg = seg;
        const char* a = seg == 0 ? A0 : seg == 1 ? A1 : seg == 2 ? A2 : A3; u.A = a + (size_t)pm * tstep; u.B = B + (size_t)seg * (1024 * 512 * 2) + (size_t)pn * tstep; return true; }
};

template <class Epi, class Sched>
__device__ __forceinline__ void gemm_phase(LAS unsigned char* lds, const int K, const Sched& S, const Epi& E) {
    int tid = threadIdx.x; asm volatile("" : "+v"(tid));
    const int wid = __builtin_amdgcn_readfirstlane(tid >> 6), lane = tid & 63, wr = wid >> 2, wc = wid & 3, fr = lane & 15, fq = lane >> 4;
    const int nt = K / BK;
    unsigned voffA[2];
#pragma unroll
    for (int i = 0; i < 2; ++i) { int R, C; stage_rc(tid * 16 + i * 8192, R, C); voffA[i] = (unsigned)(R * K + C) * 2u; }
    const size_t kstep = (size_t)(BK * 2);
    const size_t hstep = (size_t)HALF * K * 2;
    const unsigned ldsw = (unsigned)wid * 1024u;
    const int aoff = lds_byte(wr * 64 + fr, fq * 8), boff = lds_byte(wc * 32 + fr, fq * 8);
#define PG8_SA(b, h) (((b) * 2 + (h)) * HTB)
#define PG8_SB(b, h) ((4 + (b) * 2 + (h)) * HTB)
#define PG8_STAGE(bufoff, gbase) do { _Pragma("unroll") for (int _i = 0; _i < 2; ++_i) \
        __builtin_amdgcn_global_load_lds((const unsigned*)((const char*)(gbase) + voffA[_i]), (LAS unsigned*)(lds + (bufoff) + ldsw + _i * 8192), 16, 0, 0); } while (0)
#define PG8_LDA(dst, b, h) do { _Pragma("unroll") for (int m = 0; m < 4; ++m) _Pragma("unroll") for (int k = 0; k < 2; ++k) dst[m][k] = *(const LAS bf16x8*)(lds + PG8_SA(b, h) + aoff + m * 2048 + k * 1024); } while (0)
#define PG8_LDB(dst, b, h) do { _Pragma("unroll") for (int n = 0; n < 2; ++n) _Pragma("unroll") for (int k = 0; k < 2; ++k) dst[n][k] = *(const LAS bf16x8*)(lds + PG8_SB(b, h) + boff + n * 2048 + k * 1024); } while (0)
#define PG8_MMA(ai, bj, At, Bt) do { __builtin_amdgcn_s_setprio(1); _Pragma("unroll") for (int m = 0; m < 4; ++m) _Pragma("unroll") for (int n = 0; n < 2; ++n) _Pragma("unroll") for (int k = 0; k < 2; ++k) \
        acc[ai][bj][m][n] = __builtin_amdgcn_mfma_f32_16x16x32_bf16(Bt[n][k], At[m][k], acc[ai][bj][m][n], 0, 0, 0); __builtin_amdgcn_s_setprio(0); } while (0)
#define PG8_WAIT_V(n) asm volatile("s_waitcnt vmcnt(" #n ")" ::: "memory")
#define PG8_WAIT_L(n) asm volatile("s_waitcnt lgkmcnt(" #n ")" ::: "memory")
#define PG8_BAR __builtin_amdgcn_s_barrier()
#define PG8_SCHED __builtin_amdgcn_sched_barrier(0)
    Unit cur, nxt; int ui = 0;
    if (!S.next(0, cur)) return;
    f32x4 acc[2][2][4][2];
#pragma unroll
    for (int a = 0; a < 2; ++a)
#pragma unroll
        for (int b = 0; b < 2; ++b)
#pragma unroll
            for (int m = 0; m < 4; ++m)
#pragma unroll
                for (int n = 0; n < 2; ++n) acc[a][b][m][n] = (f32x4){0.f, 0.f, 0.f, 0.f};
    bf16x8 At[4][2], B0[2][2], B1[2][2];
    const char* cA = cur.A; const char* cB = cur.B;
    PG8_STAGE(PG8_SB(0, 0), cB); PG8_STAGE(PG8_SB(0, 1), cB + hstep); PG8_STAGE(PG8_SA(0, 0), cA); PG8_STAGE(PG8_SA(0, 1), cA + hstep);
    if (wr == 1) PG8_BAR;
    PG8_WAIT_V(2); PG8_BAR;
    PG8_STAGE(PG8_SB(1, 0), cB + kstep); PG8_STAGE(PG8_SA(1, 0), cA + kstep); PG8_STAGE(PG8_SB(1, 1), cB + hstep + kstep);
    PG8_WAIT_V(6); PG8_BAR;
    for (;;) {
        const bool has_next = S.next(ui + 1, nxt);
        const char* nA = has_next ? nxt.A : cA; const char* nB = has_next ? nxt.B : cB;
        for (int t = 0; t < nt; t += 2) {
            const bool last = (t == nt - 2);
            const char* a1 = cA + (size_t)(t + 1) * kstep;
            const char* a2 = last ? nA : cA + (size_t)(t + 2) * kstep; const char* b2 = last ? nB : cB + (size_t)(t + 2) * kstep;
            const char* a3 = a2 + kstep; const char* b3 = b2 + kstep;
            PG8_LDB(B0, 0, 0); PG8_LDB(B1, 0, 1); PG8_SCHED; PG8_LDA(At, 0, 0); PG8_STAGE(PG8_SA(1, 1), a1 + hstep);
            PG8_WAIT_V(8); PG8_WAIT_L(0); PG8_BAR; PG8_MMA(0, 0, At, B0); PG8_MMA(0, 1, At, B1); PG8_BAR; PG8_SCHED;
            PG8_LDA(At, 0, 1); PG8_STAGE(PG8_SB(0, 0), b2); PG8_STAGE(PG8_SB(0, 1), b2 + hstep); PG8_STAGE(PG8_SA(0, 0), a2);
            PG8_WAIT_V(8); PG8_WAIT_L(0); PG8_BAR; PG8_MMA(1, 0, At, B0); PG8_MMA(1, 1, At, B1); PG8_BAR; PG8_SCHED;
            PG8_LDB(B0, 1, 0); PG8_LDB(B1, 1, 1); PG8_SCHED; PG8_LDA(At, 1, 0); PG8_STAGE(PG8_SA(0, 1), a2 + hstep);
            PG8_WAIT_V(8); PG8_WAIT_L(0); PG8_BAR; PG8_MMA(0, 0, At, B0); PG8_MMA(0, 1, At, B1); PG8_BAR; PG8_SCHED;
            PG8_LDA(At, 1, 1); PG8_STAGE(PG8_SB(1, 0), b3); PG8_STAGE(PG8_SB(1, 1), b3 + hstep); PG8_STAGE(PG8_SA(1, 0), a3);
            PG8_WAIT_V(8); PG8_WAIT_L(0); PG8_BAR; PG8_MMA(1, 0, At, B0); PG8_MMA(1, 1, At, B1); PG8_BAR; PG8_SCHED;
        }
        if (wr == 0) PG8_BAR;
        E(acc, cur, wr, wc, fr, fq);
        if (!has_next) break;
        if constexpr (!Epi::KEEP) {
#pragma unroll
            for (int a = 0; a < 2; ++a)
#pragma unroll
                for (int b = 0; b < 2; ++b)
#pragma unroll
                    for (int m = 0; m < 4; ++m)
#pragma unroll
                        for (int n = 0; n < 2; ++n) acc[a][b][m][n] = (f32x4){0.f, 0.f, 0.f, 0.f};
        }
        cur = nxt; cA = nA; cB = nB; ++ui;
        if (wr == 1) PG8_BAR;
    }
    PG8_WAIT_V(0);
    PG8_BAR;
#undef PG8_SA
#undef PG8_SB
#undef PG8_STAGE
#undef PG8_LDA
#undef PG8_LDB
#undef PG8_MMA
#undef PG8_WAIT_V
#undef PG8_WAIT_L
#undef PG8_BAR
#undef PG8_SCHED
}
}
using pg8::Unit;

struct EpiIn {
    static constexpr bool KEEP = false;
    bf16_t *CB, *PCX, *Q, *Kb, *Vb, *U, *G; float* out; const float *qg, *kg; const f32x2* rope; int layer;
    __device__ __forceinline__ void operator()(f32x4 (&acc)[2][2][4][2], const Unit& u, int wr, int wc, int fr, int fq) const {
        const int pn = u.pn; const int rowt = u.pm * 256 + wr * 64 + fr;
        if (pn < 2 || pn >= 11) {
            bf16_t* base; int ld, col; bool sig = false;
            if (pn < 2) { base = CB; ld = 512; col = 256 * pn + 64 * wc + 16 * fq; }
            else if (pn == 11) { base = Vb; ld = 256; col = 64 * wc + 16 * fq; }
            else if (pn < 14) { base = U; ld = 512; col = 256 * (pn - 12) + 64 * wc + 16 * fq; }
            else { const int gi = (pn - 14) >> 2; base = G + (size_t)gi * MROWS * 1024; ld = 1024; col = 256 * ((pn - 14) & 3) + 64 * wc + 16 * fq; sig = true; }
#pragma unroll
            for (int ai = 0; ai < 2; ++ai)
#pragma unroll
                for (int m = 0; m < 4; ++m) {
                    const int row = rowt + 128 * ai + 16 * m;
                    f32x4 v0 = acc[ai][0][m][0], v1 = acc[ai][0][m][1], v2 = acc[ai][1][m][0], v3 = acc[ai][1][m][1];
                    if (sig) {
#pragma unroll
                        for (int i = 0; i < 4; ++i) { v0[i] = fsigmoid(fminf(fmaxf(v0[i], -30.f), 30.f)); v1[i] = fsigmoid(fminf(fmaxf(v1[i], -30.f), 30.f)); v2[i] = fsigmoid(fminf(fmaxf(v2[i], -30.f), 30.f)); v3[i] = fsigmoid(fminf(fmaxf(v3[i], -30.f), 30.f)); }
                    }
                    bf16_t* p = base + (size_t)row * ld + col;
                    *(u32x4*)p = pack8(v0, v1); *(u32x4*)(p + 8) = pack8(v2, v3);
                    if (pn == 11 && row < PROMPT_ROWS) {
                        float* o = out + OUT_CV + ((size_t)((row >> 8) * 4 + layer) * 256 + (row & 255)) * 256 + col;
                        *(f32x4*)o = v0; *(f32x4*)(o + 4) = v1; *(f32x4*)(o + 8) = v2; *(f32x4*)(o + 12) = v3;
                    }
                }
        } else if (pn < 6) {
            const int ch = 128 * (pn - 2) + 32 * wc + 8 * fq;
#pragma unroll
            for (int ai = 0; ai < 2; ++ai)
#pragma unroll
                for (int m = 0; m < 4; ++m) {
                    const int row = rowt + 128 * ai + 16 * m;
                    *(u32x4*)(PCX + (size_t)row * 512 + ch) = pack8(acc[ai][0][m][0] * acc[ai][1][m][0], acc[ai][0][m][1] * acc[ai][1][m][1]);
                }
        } else {
            const bool isq = pn < 10;
            const int half = fq >> 1, sub = fq & 1, d1 = 32 * half + 8 * sub;
            const float* gsrc = isq ? qg : kg;
            const f32x4 g1a = *(const f32x4*)(gsrc + d1), g1b = *(const f32x4*)(gsrc + d1 + 4), g2a = *(const f32x4*)(gsrc + d1 + 16), g2b = *(const f32x4*)(gsrc + d1 + 20);
#pragma unroll
            for (int ai = 0; ai < 2; ++ai)
#pragma unroll
                for (int m = 0; m < 4; ++m) {
                    const int row = rowt + 128 * ai + 16 * m;
                    f32x4 x1a = acc[ai][0][m][0], x1b = acc[ai][0][m][1], x2a = acc[ai][1][m][0], x2b = acc[ai][1][m][1];
                    float ss = 0.f;
#pragma unroll
                    for (int i = 0; i < 4; ++i) ss += x1a[i] * x1a[i] + x1b[i] * x1b[i] + x2a[i] * x2a[i] + x2b[i] * x2b[i];
                    ss += __shfl_xor(ss, 16); ss += __shfl_xor(ss, 32);
                    const float rstd = rsqrtf(ss * (1.0f / 64.0f) + RMS_EPS);
                    x1a = x1a * rstd * g1a; x1b = x1b * rstd * g1b; x2a = x2a * rstd * g2a; x2b = x2b * rstd * g2b;
                    if (!isq && row < PROMPT_ROWS) {
                        float* o = out + OUT_CK + ((size_t)((row >> 8) * 4 + layer) * 256 + (row & 255)) * 256 + 64 * wc + d1;
                        *(f32x4*)o = x1a; *(f32x4*)(o + 4) = x1b; *(f32x4*)(o + 16) = x2a; *(f32x4*)(o + 20) = x2b;
                    }
                    if (row >= PROMPT_ROWS) {
                        const int t = (row - PROMPT_ROWS) & 2047; const int pos = half ? (t & 63) : (t >> 6);
                        const f32x4* rp = (const f32x4*)(rope + pos * 16 + 8 * sub);
                        const f32x4 r0 = rp[0], r1 = rp[1], r2 = rp[2], r3 = rp[3];
                        f32x4 y1a, y1b, y2a, y2b;
                        y1a[0] = x1a[0] * r0[0] - x2a[0] * r0[1]; y2a[0] = x1a[0] * r0[1] + x2a[0] * r0[0];
                        y1a[1] = x1a[1] * r0[2] - x2a[1] * r0[3]; y2a[1] = x1a[1] * r0[3] + x2a[1] * r0[2];
                        y1a[2] = x1a[2] * r1[0] - x2a[2] * r1[1]; y2a[2] = x1a[2] * r1[1] + x2a[2] * r1[0];
                        y1a[3] = x1a[3] * r1[2] - x2a[3] * r1[3]; y2a[3] = x1a[3] * r1[3] + x2a[3] * r1[2];
                        y1b[0] = x1b[0] * r2[0] - x2b[0] * r2[1]; y2b[0] = x1b[0] * r2[1] + x2b[0] * r2[0];
                        y1b[1] = x1b[1] * r2[2] - x2b[1] * r2[3]; y2b[1] = x1b[1] * r2[3] + x2b[1] * r2[2];
                        y1b[2] = x1b[2] * r3[0] - x2b[2] * r3[1]; y2b[2] = x1b[2] * r3[1] + x2b[2] * r3[0];
                        y1b[3] = x1b[3] * r3[2] - x2b[3] * r3[3]; y2b[3] = x1b[3] * r3[3] + x2b[3] * r3[2];
                        x1a = y1a; x1b = y1b; x2a = y2a; x2b = y2b;
                    }
                    bf16_t* p;
                    if (isq) { x1a = x1a * QSCALE; x1b = x1b * QSCALE; x2a = x2a * QSCALE; x2b = x2b * QSCALE; p = Q + (size_t)row * 1024 + (4 * (pn - 6) + wc) * 64 + d1; }
                    else p = Kb + (size_t)row * 256 + wc * 64 + d1;
                    *(u32x4*)p = pack8(x1a, x1b); *(u32x4*)(p + 16) = pack8(x2a, x2b);
                }
        }
    }
};

__device__ __forceinline__ void unpack16(const bf16_t* p, f32x4& a, f32x4& b, f32x4& c, f32x4& d) {
    const u32x4 w0 = *(const u32x4*)p, w1 = *(const u32x4*)(p + 8);
    a = (f32x4){bflo(w0.x), bfhi(w0.x), bflo(w0.y), bfhi(w0.y)}; b = (f32x4){bflo(w0.z), bfhi(w0.z), bflo(w0.w), bfhi(w0.w)};
    c = (f32x4){bflo(w1.x), bfhi(w1.x), bflo(w1.y), bfhi(w1.y)}; d = (f32x4){bflo(w1.z), bfhi(w1.z), bflo(w1.w), bfhi(w1.w)};
}
__device__ __forceinline__ f32x4 rcp4(f32x4 v) { return (f32x4){__builtin_amdgcn_rcpf(v[0]), __builtin_amdgcn_rcpf(v[1]), __builtin_amdgcn_rcpf(v[2]), __builtin_amdgcn_rcpf(v[3])}; }

struct EpiProj {
    static constexpr bool KEEP = true;
    const bf16_t* G; bf16_t* MG;
    __device__ __forceinline__ void operator()(f32x4 (&acc)[2][2][4][2], const Unit& u, int wr, int wc, int fr, int fq) const {
        const int seg = u.seg; if (seg == 1) return;
        const int rowt = u.pm * 256 + wr * 64 + fr, col = 256 * u.pn + 64 * wc + 16 * fq;
        const bf16_t* Gc = G; const bf16_t* Ga = G + (size_t)MROWS * 1024; const bf16_t* Gs = G + (size_t)2 * MROWS * 1024;
#pragma unroll
        for (int ai = 0; ai < 2; ++ai)
#pragma unroll
            for (int m = 0; m < 4; ++m) {
                const size_t off = (size_t)(rowt + 128 * ai + 16 * m) * 1024 + col;
                f32x4 f0, f1, f2, f3;
                if (seg == 3) { unpack16(Gs + off, f0, f1, f2, f3); }
                else {
                    f32x4 n0, n1, n2, n3, d0, d1, d2, d3;
                    unpack16((seg == 0 ? Gc : Ga) + off, n0, n1, n2, n3); unpack16((seg == 0 ? Ga : Gs) + off, d0, d1, d2, d3);
                    f0 = n0 * rcp4(d0); f1 = n1 * rcp4(d1); f2 = n2 * rcp4(d2); f3 = n3 * rcp4(d3);
                }
                acc[ai][0][m][0] *= f0; acc[ai][0][m][1] *= f1; acc[ai][1][m][0] *= f2; acc[ai][1][m][1] *= f3;
                if (seg == 3) {
                    bf16_t* p = MG + off;
                    *(u32x4*)p = pack8(acc[ai][0][m][0], acc[ai][0][m][1]); *(u32x4*)(p + 8) = pack8(acc[ai][1][m][0], acc[ai][1][m][1]);
                    acc[ai][0][m][0] = (f32x4){0.f, 0.f, 0.f, 0.f}; acc[ai][0][m][1] = (f32x4){0.f, 0.f, 0.f, 0.f}; acc[ai][1][m][0] = (f32x4){0.f, 0.f, 0.f, 0.f}; acc[ai][1][m][1] = (f32x4){0.f, 0.f, 0.f, 0.f};
                }
            }
    }
};
struct EpiRes {
    static constexpr bool KEEP = false;
    float* X; const float* gate;
    __device__ __forceinline__ void operator()(f32x4 (&acc)[2][2][4][2], const Unit& u, int wr, int wc, int fr, int fq) const {
        const int rowt = u.pm * 256 + wr * 64 + fr, col = 256 * u.pn + 64 * wc + 16 * fq;
        const int cond = u.pm < 32 ? 0 : 1 + ((u.pm - 32) >> 3);
        const float* gp = gate + cond * 6144 + col;
        const f32x4 g0 = *(const f32x4*)gp, g1 = *(const f32x4*)(gp + 4), g2 = *(const f32x4*)(gp + 8), g3 = *(const f32x4*)(gp + 12);
#pragma unroll
        for (int ai = 0; ai < 2; ++ai)
#pragma unroll
            for (int m = 0; m < 4; ++m) {
                float* p = X + (size_t)(rowt + 128 * ai + 16 * m) * 1024 + col;
                f32x4 x0 = *(f32x4*)p, x1 = *(f32x4*)(p + 4), x2 = *(f32x4*)(p + 8), x3 = *(f32x4*)(p + 12);
                x0 += g0 * acc[ai][0][m][0]; x1 += g1 * acc[ai][0][m][1]; x2 += g2 * acc[ai][1][m][0]; x3 += g3 * acc[ai][1][m][1];
                *(f32x4*)p = x0; *(f32x4*)(p + 4) = x1; *(f32x4*)(p + 8) = x2; *(f32x4*)(p + 12) = x3;
            }
    }
};
struct EpiGlu {
    static constexpr bool KEEP = false;
    const bf16_t* YG; bf16_t* YS; const float* bias;
    __device__ __forceinline__ void operator()(f32x4 (&acc)[2][2][4][2], const Unit& u, int wr, int wc, int fr, int fq) const {
        const int rowt = u.pm * 256 + wr * 64 + fr, col = 256 * u.pn + 64 * wc + 16 * fq;
        const f32x4 b0 = *(const f32x4*)(bias + col), b1 = *(const f32x4*)(bias + col + 4), b2 = *(const f32x4*)(bias + col + 8), b3 = *(const f32x4*)(bias + col + 12);
#pragma unroll
        for (int ai = 0; ai < 2; ++ai)
#pragma unroll
            for (int m = 0; m < 4; ++m) {
                const size_t off = (size_t)(rowt + 128 * ai + 16 * m) * 512 + col;
                f32x4 y0, y1, y2, y3; unpack16(YG + off, y0, y1, y2, y3);
                f32x4 s0 = acc[ai][0][m][0] + b0, s1 = acc[ai][0][m][1] + b1, s2 = acc[ai][1][m][0] + b2, s3 = acc[ai][1][m][1] + b3;
#pragma unroll
                for (int i = 0; i < 4; ++i) { y0[i] *= fsigmoid(s0[i]); y1[i] *= fsigmoid(s1[i]); y2[i] *= fsigmoid(s2[i]); y3[i] *= fsigmoid(s3[i]); }
                *(u32x4*)(YS + off) = pack8(y0, y1); *(u32x4*)(YS + off + 8) = pack8(y2, y3);
            }
    }
};
struct EpiFfn1 {
    static constexpr bool KEEP = false;
    bf16_t* ACT;
    __device__ __forceinline__ void operator()(f32x4 (&acc)[2][2][4][2], const Unit& u, int wr, int wc, int fr, int fq) const {
        const int rowt = u.pm * 256 + wr * 64 + fr, ch = 128 * u.pn + 32 * wc + 8 * fq;
#pragma unroll
        for (int ai = 0; ai < 2; ++ai)
#pragma unroll
            for (int m = 0; m < 4; ++m) {
                f32x4 a = acc[ai][0][m][0], b = acc[ai][0][m][1];
#pragma unroll
                for (int i = 0; i < 4; ++i) { a[i] = a[i] * fsigmoid(a[i]) * acc[ai][1][m][0][i]; b[i] = b[i] * fsigmoid(b[i]) * acc[ai][1][m][1][i]; }
                *(u32x4*)(ACT + (size_t)(rowt + 128 * ai + 16 * m) * FF + ch) = pack8(a, b);
            }
    }
};

struct WSrc { const float* p; int ld; };
__device__ __forceinline__ int gen_col(int cp) { const int bj = cp >> 7, wc = (cp >> 5) & 3, n = (cp >> 4) & 1, fq = (cp >> 2) & 3, i = cp & 3; return 64 * wc + 16 * fq + 8 * bj + 4 * n + i; }
__device__ __forceinline__ WSrc wsrc(const KArgs& a, int mat, int l, int d) {
    const int pn = d >> 8, cp = d & 255; const int bj = cp >> 7, wc = (cp >> 5) & 3, n = (cp >> 4) & 1, fq = (cp >> 2) & 3, i = cp & 3;
    WSrc s;
    if (mat == 0) {
        int col;
        if (pn >= 2 && pn < 6) col = (bj ? 1024 : 512) + 128 * (pn - 2) + 32 * wc + 8 * fq + 4 * n + i;
        else if (pn >= 6 && pn < 11) col = 256 * pn + 64 * wc + 32 * (fq >> 1) + 16 * bj + 8 * (fq & 1) + 4 * n + i;
        else col = 256 * pn + gen_col(cp);
        s.p = a.in[11] + (size_t)l * 1024 * INC + col; s.ld = INC;
    } else if (mat == 1) {
        const int seg = d >> 10, dd = d & 1023; const int col = 256 * (dd >> 8) + gen_col(cp);
        const float* b = seg == 0 ? a.in[26] + (size_t)l * 512 * 1024 : seg == 1 ? a.in[27] + (size_t)l * 1024 * 1024 : seg == 2 ? a.in[27] + (size_t)l * 1024 * 1024 + 512 * 1024 : a.in[28] + (size_t)l * 512 * 1024;
        s.p = b + col; s.ld = 1024;
    } else if (mat == 2) { s.p = a.in[29] + (size_t)l * 1024 * 1024 + 256 * pn + gen_col(cp); s.ld = 1024; }
    else if (mat == 3) { s.p = a.in[24] + (size_t)l * 512 * 512 + 256 * pn + gen_col(cp); s.ld = 512; }
    else if (mat == 4) { const int ch = 128 * pn + 32 * wc + 8 * fq + 4 * n + i; s.p = (bj ? a.in[32] : a.in[31]) + (size_t)l * 1024 * FF + ch; s.ld = FF; }
    else { s.p = a.in[33] + (size_t)l * FF * 1024 + 256 * pn + gen_col(cp); s.ld = 1024; }
    return s;
}
__device__ __forceinline__ void transpose_item(const KArgs& a, int mat, int l, int K, bf16_t* WT, LAS float* scr, int item, int lane) {
    const int nkb = K / 64, kb = item % nkb, nb = item / nkb, k0 = 64 * kb, d0 = 32 * nb;
    const WSrc s = wsrc(a, mat, l, d0 + (lane & 31));
    const float* sp = s.p + (size_t)(k0 + (lane >> 5)) * s.ld;
#pragma unroll 8
    for (int i = 0; i < 32; ++i) scr[(2 * i + (lane >> 5)) * 33 + (lane & 31)] = sp[(size_t)(2 * i) * s.ld];
    asm volatile("s_waitcnt lgkmcnt(0)" ::: "memory");
    const int c = lane & 7;
#pragma unroll
    for (int j = 0; j < 4; ++j) { const int n = (lane >> 3) + 8 * j; const LAS float* q = scr + (8 * c) * 33 + n;
        u32x4 o; o.x = cvt_pk_bf16(q[0 * 33], q[1 * 33]); o.y = cvt_pk_bf16(q[2 * 33], q[3 * 33]); o.z = cvt_pk_bf16(q[4 * 33], q[5 * 33]); o.w = cvt_pk_bf16(q[6 * 33], q[7 * 33]);
        *(u32x4*)(WT + (size_t)(d0 + n) * K + k0 + 8 * c) = o; }
    asm volatile("s_waitcnt lgkmcnt(0)" ::: "memory");
}

__device__ __forceinline__ void p0_prologue(const KArgs& a, LAS unsigned char* lds, int gw, int NGW, int wave, int lane) {
    unsigned char* ws = a.ws;
    LAS float* scond = (LAS float*)(lds + 69632);
    for (int i = opaque_tid(); i < 5 * 1024; i += 512) { const float v = i < 1024 ? a.in[7][i] : a.in[2][i - 1024]; scond[i] = v * fsigmoid(v); }
    __syncthreads();
    LAS float* scr = (LAS float*)(lds + wave * 8448);
    constexpr int I0 = 16 * (INC / 32), I1 = 8 * (4096 / 32), I2 = 16 * 32, I3 = 8 * 16, I4 = 16 * (5632 / 32), I5 = 44 * 32, IL = I0 + I1 + I2 + I3 + I4 + I5;
    for (int it = gw; it < NL * IL; it += NGW) {
        const int l = it / IL; int r = it % IL;
        if (r < I0) { transpose_item(a, 0, l, 1024, (bf16_t*)(ws + OFF_WIN) + (size_t)l * INC * 1024, scr, r, lane); continue; } r -= I0;
        if (r < I1) { transpose_item(a, 1, l, 512, (bf16_t*)(ws + OFF_WPROJ) + (size_t)l * 4096 * 512, scr, r, lane); continue; } r -= I1;
        if (r < I2) { transpose_item(a, 2, l, 1024, (bf16_t*)(ws + OFF_WOUT) + (size_t)l * 1024 * 1024, scr, r, lane); continue; } r -= I2;
        if (r < I3) { transpose_item(a, 3, l, 512, (bf16_t*)(ws + OFF_WGLU) + (size_t)l * 512 * 512, scr, r, lane); continue; } r -= I3;
        if (r < I4) { transpose_item(a, 4, l, 1024, (bf16_t*)(ws + OFF_WGU) + (size_t)l * 5632 * 1024, scr, r, lane); continue; } r -= I4;
        transpose_item(a, 5, l, FF, (bf16_t*)(ws + OFF_WDN) + (size_t)l * 1024 * FF, scr, r, lane);
    }
    {
        float* MODP = (float*)(ws + OFF_MODP);
        for (int it = gw; it < NL * 24 * 16; it += NGW) {
            const int l = it / (24 * 16), rem = it % (24 * 16), cb = rem >> 4, kc = rem & 15, col = cb * 256 + lane * 4;
            f32x4 s0 = {0, 0, 0, 0}, s1 = s0, s2 = s0, s3 = s0, s4 = s0;
            const float* wp = a.in[8] + ((size_t)l * 1024 + kc * 64) * 6144 + col;
#pragma unroll 8
            for (int k = 0; k < 64; ++k) { const f32x4 w = *(const f32x4*)(wp + (size_t)k * 6144); const int kk = kc * 64 + k;
                s0 += w * scond[kk]; s1 += w * scond[1024 + kk]; s2 += w * scond[2048 + kk]; s3 += w * scond[3072 + kk]; s4 += w * scond[4096 + kk]; }
            float* o = MODP + ((size_t)(kc * NL + l) * 5) * 6144 + col;
            *(f32x4*)o = s0; *(f32x4*)(o + 6144) = s1; *(f32x4*)(o + 2 * 6144) = s2; *(f32x4*)(o + 3 * 6144) = s3; *(f32x4*)(o + 4 * 6144) = s4;
        }
    }
    for (int idx = gw; idx < 256; idx += NGW) {
        const int p = lane;
        const double dtv = exp((double)a.in[22][idx]);
        const double lr = (double)a.in[16][idx * 64 + p], li = (double)a.in[17][idx * 64 + p];
        const double mag = exp(lr * dtv); double sn, cs; dsincos(li * dtv, sn, cs);
        const double ar = mag * cs, ai = mag * sn, den = lr * lr + li * li, nre = ar - 1.0;
        const double cre = (nre * lr + ai * li) / den, cim = (ai * lr - nre * li) / den;
        ((f32x2*)(ws + OFF_SSA))[idx * 64 + p] = (f32x2){(float)ar, (float)ai};
        for (int m = 1; m <= 17; ++m) { const double mm = m == 17 ? 256.0 : (double)m; const double mg = exp(mm * lr * dtv); double s2, c2; dsincos(mm * li * dtv, s2, c2);
            ((f32x2*)(ws + OFF_PW))[((size_t)idx * 17 + (m - 1)) * 64 + p] = (f32x2){(float)(mg * c2), (float)(mg * s2)}; }
        for (int k = 0; k < 16; ++k) { const double mg = exp(16.0 * k * lr * dtv); double s2, c2; dsincos(16.0 * k * li * dtv, s2, c2);
            ((f32x2*)(ws + OFF_PW16))[((size_t)idx * 16 + k) * 64 + p] = (f32x2){(float)(mg * c2), (float)(mg * s2)}; }
        bf16_t* WZF = (bf16_t*)(ws + OFF_BBF) + (size_t)idx * 8 * 512;
        f32x2* BBR = (f32x2*)(ws + OFF_BBR) + ((size_t)idx * 64 + p) * 16;
        const float* bre = a.in[18] + ((size_t)idx * 64 + p) * 16; const float* bim = a.in[19] + ((size_t)idx * 64 + p) * 16;
        const int fi = p >> 4, rw = p & 15, sdir = (idx >> 5) & 1;
#pragma unroll
        for (int hf = 0; hf < 2; ++hf) {
            float vr[8], vi[8], wr8[8], wi8[8];
#pragma unroll
            for (int e = 0; e < 8; ++e) { const double br = bre[8 * hf + e], bi = bim[8 * hf + e]; const double xr_ = cre * br - cim * bi, xi_ = cre * bi + cim * br;
                vr[e] = (float)xr_; vi[e] = (float)xi_; wr8[e] = (float)(ar * xr_ - ai * xi_); wi8[e] = (float)(ar * xi_ + ai * xr_); BBR[8 * hf + e] = (f32x2){vr[e], vi[e]}; }
            u32x4 br_, bi_, ar_, ai_;
            br_.x = cvt_pk_bf16(vr[0], vr[1]); br_.y = cvt_pk_bf16(vr[2], vr[3]); br_.z = cvt_pk_bf16(vr[4], vr[5]); br_.w = cvt_pk_bf16(vr[6], vr[7]);
            bi_.x = cvt_pk_bf16(vi[0], vi[1]); bi_.y = cvt_pk_bf16(vi[2], vi[3]); bi_.z = cvt_pk_bf16(vi[4], vi[5]); bi_.w = cvt_pk_bf16(vi[6], vi[7]);
            ar_.x = cvt_pk_bf16(wr8[0], wr8[1]); ar_.y = cvt_pk_bf16(wr8[2], wr8[3]); ar_.z = cvt_pk_bf16(wr8[4], wr8[5]); ar_.w = cvt_pk_bf16(wr8[6], wr8[7]);
            ai_.x = cvt_pk_bf16(wi8[0], wi8[1]); ai_.y = cvt_pk_bf16(wi8[2], wi8[3]); ai_.z = cvt_pk_bf16(wi8[4], wi8[5]); ai_.w = cvt_pk_bf16(wi8[6], wi8[7]);
            const int kg0 = hf, kg1 = 2 + hf;
            *(u32x4*)(WZF + ((fi * 2 + 0) * 64 + rw + 16 * kg0) * 8) = sdir ? br_ : ar_; *(u32x4*)(WZF + ((fi * 2 + 1) * 64 + rw + 16 * kg0) * 8) = sdir ? bi_ : ai_;
            *(u32x4*)(WZF + ((fi * 2 + 0) * 64 + rw + 16 * kg1) * 8) = sdir ? ar_ : br_; *(u32x4*)(WZF + ((fi * 2 + 1) * 64 + rw + 16 * kg1) * 8) = sdir ? ai_ : bi_;
        }
        bf16_t* CCF = (bf16_t*)(ws + OFF_CCF) + (size_t)idx * 4 * 512;
        const int kk = p >> 4, gq = (p >> 2) & 3, e = p & 3;
        for (int c = 0; c < 16; ++c) {
            const float crv = a.in[20][((size_t)idx * 16 + c) * 64 + p], civ = a.in[21][((size_t)idx * 16 + c) * 64 + p];
            bf16_t* q = CCF + (kk * 64 + c + 16 * gq) * 8;
            q[e] = (bf16_t)(cvt_pk_bf16(crv, 0.f) & 0xffffu); q[4 + e] = (bf16_t)(cvt_pk_bf16(-civ, 0.f) & 0xffffu);
        }
    }
    const int gt = blockIdx.x * 512 + opaque_tid(), NT = gridDim.x * 512;
    if (gt < 1024) { const int pos = gt >> 4, j = gt & 15; const double inv = exp(-(double)j * (9.210340371976184 / 16.0)); double sn, cs; dsincos((double)pos * inv, sn, cs);
        ((f32x2*)(ws + OFF_ROPE))[gt] = (f32x2){(float)cs, (float)sn}; }
    for (int i = gt; i < 4 * 4 * 256 * 256 / 4; i += NT) {
        const f32x4 k4 = ((const f32x4*)a.in[3])[i], v4 = ((const f32x4*)a.in[4])[i];
        ((u32x2*)(ws + OFF_KC))[i] = (u32x2){cvt_pk_bf16(k4[0], k4[1]), cvt_pk_bf16(k4[2], k4[3])};
        ((u32x2*)(ws + OFF_VC))[i] = (u32x2){cvt_pk_bf16(v4[0], v4[1]), cvt_pk_bf16(v4[2], v4[3])};
    }
}
__device__ __forceinline__ void p0_toeplitz(const KArgs& a, int gw, int NGW, int lane) {
    unsigned char* ws = a.ws;
    const int c = lane >> 2, cq = lane & 3;
    for (int it = gw; it < 256 * 16; it += NGW) {
        const int idx = it >> 4, dl = it & 15, sdir = (idx >> 5) & 1;
        const float* crp = a.in[20] + ((size_t)idx * 16 + c) * 64; const float* cip = a.in[21] + ((size_t)idx * 16 + c) * 64;
        const f32x2* pwp = (const f32x2*)(ws + OFF_PW) + ((size_t)idx * 17 + (dl > 0 ? dl - 1 : 0)) * 64;
        const f32x2* bbp = (const f32x2*)(ws + OFF_BBR) + (size_t)idx * 64 * 16 + 4 * cq;
        float k0 = 0.f, k1 = 0.f, k2 = 0.f, k3 = 0.f;
#pragma unroll 4
        for (int p = 0; p < 64; ++p) {
            const float cr = crp[p], ci = cip[p]; f32x2 pw = pwp[p]; if (dl == 0) pw = (f32x2){1.f, 0.f};
            const float wr_ = cr * pw[0] - ci * pw[1], wi_ = cr * pw[1] + ci * pw[0];
            const f32x4 b01 = *(const f32x4*)(bbp + p * 16), b23 = *(const f32x4*)(bbp + p * 16 + 2);
            k0 += wr_ * b01[0] - wi_ * b01[1]; k1 += wr_ * b01[2] - wi_ * b01[3]; k2 += wr_ * b23[0] - wi_ * b23[1]; k3 += wr_ * b23[2] - wi_ * b23[3];
        }
        const u32x2 kv = {cvt_pk_bf16(k0, k1), cvt_pk_bf16(k2, k3)}; const u32x2 zz = {0u, 0u};
        bf16_t* TF = (bf16_t*)(ws + OFF_TF) + (size_t)idx * 16 * 512;
        const int ea = sdir ? 1 : 0, eb = 1 - ea;
        *(u32x2*)(TF + (dl * 64 + c + 16 * (2 * ea + (cq >> 1))) * 8 + 4 * (cq & 1)) = kv;
        if (dl < 15) *(u32x2*)(TF + ((dl + 1) * 64 + c + 16 * (2 * eb + (cq >> 1))) * 8 + 4 * (cq & 1)) = kv;
        if (dl == 0) *(u32x2*)(TF + (c + 16 * (2 * eb + (cq >> 1))) * 8 + 4 * (cq & 1)) = zz;
    }
}
__device__ __forceinline__ void p0_mod_reduce(const KArgs& a) {
    const float* MODP = (const float*)(a.ws + OFF_MODP); float* MOD = (float*)(a.ws + OFF_MOD);
    const int gt = blockIdx.x * 512 + opaque_tid(), NT = gridDim.x * 512;
    for (int i = gt; i < NL * 5 * 6144; i += NT) {
        const int l = i / (5 * 6144), col = i % 6144;
        float s = a.in[9][l * 6144 + col];
#pragma unroll
        for (int kc = 0; kc < 16; ++kc) s += MODP[(size_t)kc * NL * 5 * 6144 + i];
        MOD[i] = s;
    }
}

__device__ __forceinline__ void norm_phase(const KArgs& a, int layer, bool first, const float* g, const float* modl, int shift_off, int scale_off, int gw, int NGW, int lane) {
    float* X = a.out; bf16_t* H = (bf16_t*)(a.ws + OFF_H);
    for (int row0 = gw; row0 < MROWS; row0 += 2 * NGW) {
        f32x4 v[2][4]; float ss[2] = {0.f, 0.f};
#pragma unroll
        for (int q = 0; q < 2; ++q) {
            const int row = row0 + q * NGW;
            const float* xr = first ? (row < PROMPT_ROWS ? a.in[0] + (size_t)row * 1024 : a.in[1] + (size_t)(row - PROMPT_ROWS) * 1024) : X + (size_t)row * 1024;
#pragma unroll
            for (int j = 0; j < 4; ++j) v[q][j] = *(const f32x4*)(xr + 4 * lane + 256 * j);
        }
#pragma unroll
        for (int q = 0; q < 2; ++q) {
            const int row = row0 + q * NGW;
#pragma unroll
            for (int j = 0; j < 4; ++j) ss[q] += v[q][j][0] * v[q][j][0] + v[q][j][1] * v[q][j][1] + v[q][j][2] * v[q][j][2] + v[q][j][3] * v[q][j][3];
            const float rstd = rsqrtf(wave_sum(ss[q]) * (1.0f / 1024.0f) + RMS_EPS);
            const int cond = row < PROMPT_ROWS ? 0 : 1 + ((row - PROMPT_ROWS) >> 11);
            const float* sh = modl + cond * 6144 + shift_off; const float* sc = modl + cond * 6144 + scale_off;
#pragma unroll
            for (int j = 0; j < 4; ++j) {
                const int col = 4 * lane + 256 * j;
                const f32x4 gg = *(const f32x4*)(g + col), s4 = *(const f32x4*)(sc + col), h4 = *(const f32x4*)(sh + col);
                const f32x4 o = v[q][j] * rstd * gg * (s4 + 1.0f) + h4;
                *(u32x2*)(H + (size_t)row * 1024 + col) = (u32x2){cvt_pk_bf16(o[0], o[1]), cvt_pk_bf16(o[2], o[3])};
                if (first) *(f32x4*)(X + (size_t)row * 1024 + col) = v[q][j];
            }
        }
    }
}
__device__ __forceinline__ void final_norm_phase(const KArgs& a, int gw, int NGW, int lane) {
    float* X = a.out; const float* g = a.in[34];
    for (int row = gw; row < MROWS; row += NGW) {
        float* xr = X + (size_t)row * 1024; f32x4 v[4]; float ss = 0.f;
#pragma unroll
        for (int j = 0; j < 4; ++j) { v[j] = *(const f32x4*)(xr + 4 * lane + 256 * j); ss += v[j][0] * v[j][0] + v[j][1] * v[j][1] + v[j][2] * v[j][2] + v[j][3] * v[j][3]; }
        const float rstd = rsqrtf(wave_sum(ss) * (1.0f / 1024.0f) + RMS_EPS);
#pragma unroll
        for (int j = 0; j < 4; ++j) { const int col = 4 * lane + 256 * j; *(f32x4*)(xr + col) = v[j] * rstd * *(const f32x4*)(g + col); }
    }
}

template <int CTRL> __device__ __forceinline__ float dppf(float v) { return __builtin_bit_cast(float, __builtin_amdgcn_update_dpp(0, __builtin_bit_cast(int, v), CTRL, 0xf, 0xf, true)); }
template <int D, bool BWD, bool SQ> __device__ __forceinline__ void scan_step(f32x4 (&xr)[2], f32x4 (&xi)[2], f32x4 (&pr)[2], f32x4 (&pi)[2]) {
    constexpr int CTRL = BWD ? (0x100 + D) : (0x110 + D);
#pragma unroll
    for (int i = 0; i < 2; ++i)
#pragma unroll
        for (int j = 0; j < 4; ++j) {
            const float tr = dppf<CTRL>(xr[i][j]), ti = dppf<CTRL>(xi[i][j]);
            xr[i][j] += pr[i][j] * tr - pi[i][j] * ti; xi[i][j] += pr[i][j] * ti + pi[i][j] * tr;
            if (SQ) { const float a = pr[i][j], b = pi[i][j]; pr[i][j] = a * a - b * b; pi[i][j] = 2.f * a * b; }
        }
}
constexpr int SSM_DIRB = 28 * 1024, SSM_EOFF = 2 * SSM_DIRB;
__device__ __forceinline__ void cload4(const f32x2* p, f32x4& re, f32x4& im) { const f32x4 s0 = ((const f32x4*)p)[0], s1 = ((const f32x4*)p)[1]; re = (f32x4){s0[0], s0[2], s1[0], s1[2]}; im = (f32x4){s0[1], s0[3], s1[1], s1[3]}; }
template <bool BWD> __device__ __forceinline__ void ssm_in(const KArgs& a, const LAS unsigned char* lc, LAS float* E, const bf16x8 (&uf)[8], f32x4 (&hpr)[4], f32x4 (&hpi)[4],
                                                            int layer, bool sample, int seq, int seg, int g, int lane_in) {
    int lane = lane_in; asm volatile("" : "+v"(lane));
    constexpr int dir = BWD ? 1 : 0;
    unsigned char* ws = a.ws;
    const int n = lane & 15, gq = lane >> 4, idx = (layer * 2 + dir) * 32 + g;
    const LAS unsigned char* lf = lc + dir * SSM_DIRB + lane * 16;
    f32x4 a2r[4], a2i[4], sr[4], si[4];
#pragma unroll
    for (int i = 0; i < 4; ++i) { f32x4 ar, ai; cload4((const f32x2*)(ws + OFF_SSA) + idx * 64 + 16 * i + 4 * gq, ar, ai); a2r[i] = ar * ar - ai * ai; a2i[i] = 2.f * ar * ai; }
    const f32x4 z4 = {0.f, 0.f, 0.f, 0.f};
#pragma unroll
    for (int jj = 0; jj < 8; ++jj) {
        const int j = BWD ? 7 - jj : jj;
#pragma unroll
        for (int i = 0; i < 4; ++i) {
            f32x4 cr = z4, ci = z4;
            if (jj > 0) { cr = a2r[i] * sr[i] - a2i[i] * si[i]; ci = a2r[i] * si[i] + a2i[i] * sr[i]; }
            sr[i] = __builtin_amdgcn_mfma_f32_16x16x32_bf16(*(const LAS bf16x8*)(lf + (2 * i) * 1024), uf[j], cr, 0, 0, 0);
            si[i] = __builtin_amdgcn_mfma_f32_16x16x32_bf16(*(const LAS bf16x8*)(lf + (2 * i + 1) * 1024), uf[j], ci, 0, 0, 0);
        }
    }
#pragma unroll
    for (int hf = 0; hf < 2; ++hf) {
        f32x4 xr[2] = {sr[2 * hf], sr[2 * hf + 1]}, xi[2] = {si[2 * hf], si[2 * hf + 1]}, pr[2], pi[2];
        cload4((const f32x2*)(ws + OFF_PW) + ((size_t)idx * 17 + 15) * 64 + 16 * (2 * hf) + 4 * gq, pr[0], pi[0]);
        cload4((const f32x2*)(ws + OFF_PW) + ((size_t)idx * 17 + 15) * 64 + 16 * (2 * hf + 1) + 4 * gq, pr[1], pi[1]);
        scan_step<1, BWD, true>(xr, xi, pr, pi); scan_step<2, BWD, true>(xr, xi, pr, pi); scan_step<4, BWD, true>(xr, xi, pr, pi); scan_step<8, BWD, false>(xr, xi, pr, pi);
        sr[2 * hf] = xr[0]; sr[2 * hf + 1] = xr[1]; si[2 * hf] = xi[0]; si[2 * hf + 1] = xi[1];
    }
    if (n == (BWD ? 0 : 15)) {
        if (!sample) {
            const size_t so = ((size_t)((seq * 4 + layer) * 2 + dir) * 32 + g) * 64 + 4 * gq;
#pragma unroll
            for (int i = 0; i < 4; ++i) { *(f32x4*)(a.out + OUT_SR + so + 16 * i) = sr[i]; *(f32x4*)(a.out + OUT_SI + so + 16 * i) = si[i]; }
        } else {
            LAS float* e = E + ((dir * 8 + seg) * 64 + 4 * gq) * 2;
#pragma unroll
            for (int i = 0; i < 4; ++i) { *(LAS f32x4*)(e + 32 * i) = (f32x4){sr[i][0], si[i][0], sr[i][1], si[i][1]}; *(LAS f32x4*)(e + 32 * i + 4) = (f32x4){sr[i][2], si[i][2], sr[i][3], si[i][3]}; }
        }
    }
#pragma unroll
    for (int i = 0; i < 4; ++i)
#pragma unroll
        for (int j = 0; j < 4; ++j) { hpr[i][j] = dppf<BWD ? 0x101 : 0x111>(sr[i][j]); hpi[i][j] = dppf<BWD ? 0x101 : 0x111>(si[i][j]); }
}
template <bool BWD> __device__ __forceinline__ void ssm_out(const KArgs& a, const LAS unsigned char* lc, const LAS float* E, const bf16x8 (&uf)[8], f32x4 (&gr)[4], f32x4 (&gi)[4],
                                                             int layer, bool sample, int sq, int seg, int rowbase, int g, int lane_in) {
    int lane = lane_in; asm volatile("" : "+v"(lane));
    constexpr int dir = BWD ? 1 : 0;
    unsigned char* ws = a.ws;
    const int n = lane & 15, gq = lane >> 4, idx = (layer * 2 + dir) * 32 + g;
    const LAS unsigned char* lf = lc + dir * SSM_DIRB + lane * 16;
    const bf16_t* U = (const bf16_t*)(ws + OFF_U);
    float* YF = (float*)(ws + OFF_H); bf16_t* YG = (bf16_t*)(ws + OFF_YG);
    f32x4 are[4], aim[4];
#pragma unroll
    for (int i = 0; i < 4; ++i) {
        const int p0 = 16 * i + 4 * gq;
        cload4((const f32x2*)(ws + OFF_SSA) + idx * 64 + p0, are[i], aim[i]);
        if (sample) {
            f32x4 br, bi; cload4((const f32x2*)(ws + OFF_PW) + ((size_t)idx * 17 + 16) * 64 + p0, br, bi);
            const size_t so = ((size_t)((sq * 4 + layer) * 2 + dir) * 32 + g) * 64 + p0;
            f32x4 hr = *(const f32x4*)(a.in[5] + so), hi = *(const f32x4*)(a.in[6] + so);
            const int cnt = BWD ? 7 - seg : seg;
#pragma unroll 1
            for (int k = 0; k < cnt; ++k) {
                const int sidx = BWD ? 7 - k : k;
                f32x4 er, ei; { const LAS float* e = E + ((dir * 8 + sidx) * 64 + p0) * 2; const f32x4 e0 = *(const LAS f32x4*)e, e1 = *(const LAS f32x4*)(e + 4); er = (f32x4){e0[0], e0[2], e1[0], e1[2]}; ei = (f32x4){e0[1], e0[3], e1[1], e1[3]}; }
                const f32x4 t = br * hr - bi * hi + er; hi = br * hi + bi * hr + ei; hr = t;
            }
            f32x4 qr, qi; cload4((const f32x2*)(ws + OFF_PW16) + ((size_t)idx * 16 + (BWD ? 15 - n : n)) * 64 + p0, qr, qi);
            gr[i] += qr * hr - qi * hi; gi[i] += qr * hi + qi * hr;
        }
        { const f32x4 t = are[i] * gr[i] - aim[i] * gi[i]; gi[i] = are[i] * gi[i] + aim[i] * gr[i]; gr[i] = t; }
        __builtin_amdgcn_sched_barrier(0);
    }
    const f32x4 dvec = *(const f32x4*)(a.in[23] + layer * 512 + g * 16 + 4 * gq);
    const f32x4 z4 = {0.f, 0.f, 0.f, 0.f};
#pragma unroll
    for (int tt = 0; tt < 16; ++tt) {
        const int t = BWD ? 15 - tt : tt;
        const size_t tok = (size_t)rowbase + 16 * n + t;
        f32x4 y = z4;
#pragma unroll
        for (int i = 0; i < 4; ++i) {
            u32x4 w; w.x = cvt_pk_bf16(gr[i][0], gr[i][1]); w.y = cvt_pk_bf16(gr[i][2], gr[i][3]); w.z = cvt_pk_bf16(gi[i][0], gi[i][1]); w.w = cvt_pk_bf16(gi[i][2], gi[i][3]);
            y = __builtin_amdgcn_mfma_f32_16x16x32_bf16(*(const LAS bf16x8*)(lf + (24 + i) * 1024), __builtin_bit_cast(bf16x8, w), y, 0, 0, 0);
        }
        if (!BWD) {
#pragma unroll
            for (int j = 0; j < 8; ++j) if (2 * j <= t) y = __builtin_amdgcn_mfma_f32_16x16x32_bf16(*(const LAS bf16x8*)(lf + (8 + t - 2 * j) * 1024), uf[j], y, 0, 0, 0);
        } else {
#pragma unroll
            for (int j = 0; j < 8; ++j) if (2 * j + 1 >= t) y = __builtin_amdgcn_mfma_f32_16x16x32_bf16(*(const LAS bf16x8*)(lf + (8 + 2 * j + 1 - t) * 1024), uf[j], y, 0, 0, 0);
        }
        float* yfp = YF + tok * 512 + g * 16 + 4 * gq;
        if (!BWD) *(f32x4*)yfp = y;
        else {
            const f32x4 yf = *(const f32x4*)yfp; const u32x2 uw = *(const u32x2*)(U + tok * 512 + g * 16 + 4 * gq);
            f32x4 v = y + yf + dvec * (f32x4){bflo(uw.x), bfhi(uw.x), bflo(uw.y), bfhi(uw.y)};
#pragma unroll
            for (int j = 0; j < 4; ++j) { const float x = v[j]; const float z = 0.7978845608028654f * (x + 0.044715f * x * x * x); const float th = 1.0f - 2.0f * __builtin_amdgcn_rcpf(1.0f + __expf(2.0f * z)); v[j] = 0.5f * x * (1.0f + th); }
            *(u32x2*)(YG + tok * 512 + g * 16 + 4 * gq) = (u32x2){cvt_pk_bf16(v[0], v[1]), cvt_pk_bf16(v[2], v[3])};
        }
        if (tt < 15) {
#pragma unroll
            for (int i = 0; i < 4; ++i) { const f32x4 t_ = are[i] * gr[i] - aim[i] * gi[i]; gi[i] = are[i] * gi[i] + aim[i] * gr[i]; gr[i] = t_; }
        }
    }
}
__device__ __forceinline__ void ssm_phase(const KArgs& a, LAS unsigned char* lds, int layer, int wave, int lane) {
    unsigned char* ws = a.ws;
    LAS float* E = (LAS float*)(lds + SSM_EOFF);
    for (int bi = opaque_bid(); bi < 256; bi += gridDim.x) {
        const int g = bi & 31; const bool sample = bi < 128;
        const int sq = bi >> 5, seq = sample ? 0 : 8 * ((bi - 128) >> 5) + wave;
        const int rowbase = sample ? PROMPT_ROWS + sq * 2048 + wave * 256 : seq * 256;
        __syncthreads();
        for (int f = wave; f < 56; f += 8) {
            const int d = f / 28, ff = f % 28, idx = (layer * 2 + d) * 32 + g;
            const bf16_t* src = ff < 8 ? (const bf16_t*)(ws + OFF_BBF) + ((size_t)idx * 8 + ff) * 512 : ff < 24 ? (const bf16_t*)(ws + OFF_TF) + ((size_t)idx * 16 + ff - 8) * 512 : (const bf16_t*)(ws + OFF_CCF) + ((size_t)idx * 4 + ff - 24) * 512;
            *(LAS u32x4*)(lds + d * SSM_DIRB + ff * 1024 + lane * 16) = *(const u32x4*)(src + lane * 8);
        }
        bf16x8 uf[8];
        { const int n = lane & 15, gq = lane >> 4;
#pragma unroll
          for (int j = 0; j < 8; ++j) uf[j] = *(const bf16x8*)((const bf16_t*)(ws + OFF_U) + ((size_t)rowbase + 16 * n + 2 * j + (gq >> 1)) * 512 + g * 16 + 8 * (gq & 1)); }
        asm volatile("s_waitcnt vmcnt(0) lgkmcnt(0)" ::: "memory");
        __syncthreads();
        f32x4 hfr[4], hfi[4], hbr[4], hbi[4];
        ssm_in<false>(a, lds, E, uf, hfr, hfi, layer, sample, seq, wave, g, lane);
        ssm_in<true>(a, lds, E, uf, hbr, hbi, layer, sample, seq, wave, g, lane);
        asm volatile("s_waitcnt vmcnt(0) lgkmcnt(0)" ::: "memory");
        __syncthreads();
        ssm_out<false>(a, lds, E, uf, hfr, hfi, layer, sample, sq, wave, rowbase, g, lane);
        ssm_out<true>(a, lds, E, uf, hbr, hbi, layer, sample, sq, wave, rowbase, g, lane);
    }
}
__device__ __forceinline__ void conv_phase(const KArgs& a, int layer, int part, int nparts) {
    const int G = nparts;
    bf16_t* CB = (bf16_t*)(a.ws + OFF_CB); const bf16_t* P = (const bf16_t*)(a.ws + OFF_PCX);
    const float* cw = a.in[12] + layer * 3 * 512; const float* cbias = a.in[13] + layer * 512;
    const int gt = part * 512 + opaque_tid(), NT = G * 512;
    for (int i = gt; i < MROWS * 64; i += NT) {
        const int row = i >> 6, ch = (i & 63) * 8;
        const int t = row < PROMPT_ROWS ? (row & 255) : ((row - PROMPT_ROWS) & 2047), L = row < PROMPT_ROWS ? 256 : 2048;
        const u32x4 z = {0, 0, 0, 0};
        const u32x4 pc = *(const u32x4*)(P + (size_t)row * 512 + ch);
        const u32x4 pl = t > 0 ? *(const u32x4*)(P + (size_t)(row - 1) * 512 + ch) : z;
        const u32x4 pr = t < L - 1 ? *(const u32x4*)(P + (size_t)(row + 1) * 512 + ch) : z;
        const u32x4 cbv = *(const u32x4*)(CB + (size_t)row * 512 + ch);
        float o[8];
#pragma unroll
        for (int e = 0; e < 4; ++e) {
            const unsigned wl = e == 0 ? pl.x : e == 1 ? pl.y : e == 2 ? pl.z : pl.w, wc_ = e == 0 ? pc.x : e == 1 ? pc.y : e == 2 ? pc.z : pc.w, wr_ = e == 0 ? pr.x : e == 1 ? pr.y : e == 2 ? pr.z : pr.w, wb = e == 0 ? cbv.x : e == 1 ? cbv.y : e == 2 ? cbv.z : cbv.w;
            const int c0 = ch + 2 * e;
            o[2 * e] = bflo(wb) * (cw[c0] * bflo(wl) + cw[512 + c0] * bflo(wc_) + cw[1024 + c0] * bflo(wr_) + cbias[c0]);
            o[2 * e + 1] = bfhi(wb) * (cw[c0 + 1] * bfhi(wl) + cw[512 + c0 + 1] * bfhi(wc_) + cw[1024 + c0 + 1] * bfhi(wr_) + cbias[c0 + 1]);
        }
        u32x4 w; w.x = cvt_pk_bf16(o[0], o[1]); w.y = cvt_pk_bf16(o[2], o[3]); w.z = cvt_pk_bf16(o[4], o[5]); w.w = cvt_pk_bf16(o[6], o[7]);
        *(u32x4*)(CB + (size_t)row * 512 + ch) = w;
    }
}

constexpr int AT_KSTR = 144, AT_VSTR = 192, AT_VOFF = 64 * AT_KSTR, AT_BUF = AT_VOFF + 64 * AT_VSTR;
__device__ __forceinline__ s16x4 tr_read(const LAS unsigned char* p) { typedef short v4i16_t __attribute__((ext_vector_type(4))); return __builtin_bit_cast(s16x4, __builtin_amdgcn_ds_read_tr16_b64_v4i16((LAS v4i16_t*)p)); }
__device__ __forceinline__ void attn_unit(const KArgs& a, LAS unsigned char* lds, int layer, int unit) {
    unsigned char* ws = a.ws;
    const bf16_t* Q = (const bf16_t*)(ws + OFF_Q); const bf16_t* Kb = (const bf16_t*)(ws + OFF_K); const bf16_t* Vb = (const bf16_t*)(ws + OFF_V);
    bf16_t* YA = (bf16_t*)(ws + OFF_YA);
    int b, kvh, qb, rowbase, NTL, NT;
    if (unit < 256) { b = unit >> 6; kvh = (unit >> 4) & 3; qb = unit & 15; rowbase = PROMPT_ROWS + b * 2048; NTL = 32; NT = 36; }
    else { const int u2 = unit - 256; b = u2 >> 3; kvh = (u2 >> 1) & 3; qb = u2 & 1; rowbase = b * 256; NTL = 4; NT = 4; }
    int tid = threadIdx.x; asm volatile("" : "+v"(tid));
    const int lane = tid & 63, w = tid >> 6, r32 = lane & 31, hi = lane >> 5;
    const int hq = kvh * 4 + (w >> 1); const size_t qrow0 = (size_t)rowbase + qb * 128 + 32 * (w & 1) + r32;
    bf16x8 qr[2][4];
#pragma unroll
    for (int s_ = 0; s_ < 2; ++s_)
#pragma unroll
        for (int d0 = 0; d0 < 4; ++d0) qr[s_][d0] = *(const bf16x8*)(Q + (qrow0 + 64 * s_) * 1024 + hq * 64 + 16 * d0 + 8 * hi);
    const int lkey = tid >> 3, lch = tid & 7;
    const bf16_t* kc = (const bf16_t*)(ws + OFF_KC) + ((size_t)(b * 4 + layer) * 256) * 256; const bf16_t* vc = (const bf16_t*)(ws + OFF_VC) + ((size_t)(b * 4 + layer) * 256) * 256;
    u32x4 kreg, vreg;
#define AT_LOAD(t) do { const size_t _o = ((t) < NTL ? ((size_t)rowbase + (t) * 64 + lkey) : (size_t)(((t) - NTL) * 64 + lkey)) * 256 + kvh * 64 + lch * 8; \
        kreg = *(const u32x4*)(((t) < NTL ? Kb : kc) + _o); vreg = *(const u32x4*)(((t) < NTL ? Vb : vc) + _o); } while (0)
#define AT_STORE(buf) do { *(LAS u32x4*)(lds + (buf) * AT_BUF + lkey * AT_KSTR + lch * 16) = kreg; *(LAS u32x4*)(lds + (buf) * AT_BUF + AT_VOFF + lkey * AT_VSTR + lch * 16) = vreg; } while (0)
    AT_LOAD(0); AT_STORE(0);
    __syncthreads();
    f32x16 o0[2], o1[2];
#pragma unroll
    for (int r = 0; r < 16; ++r) { o0[0][r] = 0.f; o1[0][r] = 0.f; o0[1][r] = 0.f; o1[1][r] = 0.f; }
    float mrun[2] = {0.f, 0.f}, lrun[2] = {0.f, 0.f};
    const int vlane = ((lane & 15) >> 2) * AT_VSTR + (16 * ((lane >> 4) & 1) + 4 * (lane & 3)) * 2;
    for (int t = 0; t < NT; ++t) {
        if (t + 1 < NT) AT_LOAD(t + 1);
        const LAS unsigned char* Ks = lds + (t & 1) * AT_BUF; const LAS unsigned char* Vs = Ks + AT_VOFF;
        f32x16 p0[2], p1[2];
#pragma unroll
        for (int r = 0; r < 16; ++r) { p0[0][r] = -mrun[0]; p1[0][r] = -mrun[0]; p0[1][r] = -mrun[1]; p1[1][r] = -mrun[1]; }
#pragma unroll
        for (int d0 = 0; d0 < 4; ++d0) {
            const bf16x8 k0 = *(const LAS bf16x8*)(Ks + r32 * AT_KSTR + d0 * 32 + hi * 16);
            const bf16x8 k1 = *(const LAS bf16x8*)(Ks + (32 + r32) * AT_KSTR + d0 * 32 + hi * 16);
            p0[0] = __builtin_amdgcn_mfma_f32_32x32x16_bf16(k0, qr[0][d0], p0[0], 0, 0, 0);
            p1[0] = __builtin_amdgcn_mfma_f32_32x32x16_bf16(k1, qr[0][d0], p1[0], 0, 0, 0);
            p0[1] = __builtin_amdgcn_mfma_f32_32x32x16_bf16(k0, qr[1][d0], p0[1], 0, 0, 0);
            p1[1] = __builtin_amdgcn_mfma_f32_32x32x16_bf16(k1, qr[1][d0], p1[1], 0, 0, 0);
        }
        float tmax[2];
#pragma unroll
        for (int s_ = 0; s_ < 2; ++s_) {
            float m = p0[s_][0];
#pragma unroll
            for (int r = 0; r < 16; ++r) { m = fmaxf(m, p0[s_][r]); m = fmaxf(m, p1[s_][r]); }
            tmax[s_] = fmaxf(m, __shfl_xor(m, 32));
        }
        if (t == 0 || __builtin_amdgcn_ballot_w64(fmaxf(tmax[0], tmax[1]) > 8.0f) != 0ull) {
#pragma unroll
            for (int s_ = 0; s_ < 2; ++s_) {
                const float delta = t == 0 ? tmax[s_] : fmaxf(tmax[s_], 0.f), alpha = __builtin_amdgcn_exp2f(-delta);
                mrun[s_] += delta; lrun[s_] *= alpha;
#pragma unroll
                for (int r = 0; r < 16; ++r) { p0[s_][r] -= delta; p1[s_][r] -= delta; o0[s_][r] *= alpha; o1[s_][r] *= alpha; }
            }
        }
#pragma unroll
        for (int s_ = 0; s_ < 2; ++s_) {
            float psum = 0.f;
#pragma unroll
            for (int r = 0; r < 16; ++r) { p0[s_][r] = __builtin_amdgcn_exp2f(p0[s_][r]); p1[s_][r] = __builtin_amdgcn_exp2f(p1[s_][r]); psum += p0[s_][r] + p1[s_][r]; }
            lrun[s_] += psum;
        }
#pragma unroll
        for (int kh = 0; kh < 2; ++kh)
#pragma unroll
            for (int kk = 0; kk < 2; ++kk) {
                const LAS unsigned char* vb = Vs + (32 * kh + 16 * kk + 4 * hi) * AT_VSTR + vlane;
                const s16x4 a0 = tr_read(vb), a1 = tr_read(vb + 8 * AT_VSTR), c0 = tr_read(vb + 64), c1 = tr_read(vb + 8 * AT_VSTR + 64);
                const bf16x8 vf0 = {a0[0], a0[1], a0[2], a0[3], a1[0], a1[1], a1[2], a1[3]}, vf1 = {c0[0], c0[1], c0[2], c0[3], c1[0], c1[1], c1[2], c1[3]};
#pragma unroll
                for (int s_ = 0; s_ < 2; ++s_) {
                    u32x4 pw;
                    if (kh == 0) { pw.x = cvt_pk_bf16(p0[s_][8 * kk], p0[s_][8 * kk + 1]); pw.y = cvt_pk_bf16(p0[s_][8 * kk + 2], p0[s_][8 * kk + 3]); pw.z = cvt_pk_bf16(p0[s_][8 * kk + 4], p0[s_][8 * kk + 5]); pw.w = cvt_pk_bf16(p0[s_][8 * kk + 6], p0[s_][8 * kk + 7]); }
                    else { pw.x = cvt_pk_bf16(p1[s_][8 * kk], p1[s_][8 * kk + 1]); pw.y = cvt_pk_bf16(p1[s_][8 * kk + 2], p1[s_][8 * kk + 3]); pw.z = cvt_pk_bf16(p1[s_][8 * kk + 4], p1[s_][8 * kk + 5]); pw.w = cvt_pk_bf16(p1[s_][8 * kk + 6], p1[s_][8 * kk + 7]); }
                    const bf16x8 pf = __builtin_bit_cast(bf16x8, pw);
                    o0[s_] = __builtin_amdgcn_mfma_f32_32x32x16_bf16(vf0, pf, o0[s_], 0, 0, 0);
                    o1[s_] = __builtin_amdgcn_mfma_f32_32x32x16_bf16(vf1, pf, o1[s_], 0, 0, 0);
                }
            }
        if (t + 1 < NT) AT_STORE((t + 1) & 1);
        __syncthreads();
    }
#undef AT_LOAD
#undef AT_STORE
#pragma unroll
    for (int s_ = 0; s_ < 2; ++s_) {
        const float inv = __builtin_amdgcn_rcpf(lrun[s_] + __shfl_xor(lrun[s_], 32));
        bf16_t* op = YA + (size_t)(hq >> 3) * MROWS * 512 + (qrow0 + 64 * s_) * 512 + (hq & 7) * 64 + 4 * hi;
#pragma unroll
        for (int q4 = 0; q4 < 4; ++q4) {
            *(u32x2*)(op + 8 * q4) = (u32x2){cvt_pk_bf16(o0[s_][4 * q4] * inv, o0[s_][4 * q4 + 1] * inv), cvt_pk_bf16(o0[s_][4 * q4 + 2] * inv, o0[s_][4 * q4 + 3] * inv)};
            *(u32x2*)(op + 32 + 8 * q4) = (u32x2){cvt_pk_bf16(o1[s_][4 * q4] * inv, o1[s_][4 * q4 + 1] * inv), cvt_pk_bf16(o1[s_][4 * q4 + 2] * inv, o1[s_][4 * q4 + 3] * inv)};
        }
    }
}

#define XB_TMO      128
#define XB_XCNT(j)  (256  + 64 * (j))
#define XB_XSUB(j)  (1280 + 64 * (j))
#define XB_XGEN(j)  (2304 + 64 * (j))
#define XB_TOP      3328
#define XB_TOPGEN   3392
#define XCD_BAR_WORDS 3456
#define XB_SPIN_CAP (1u << 18)
__device__ __forceinline__ unsigned xb_ld(unsigned* p)              { return __hip_atomic_load(p, __ATOMIC_RELAXED, __HIP_MEMORY_SCOPE_AGENT); }
__device__ __forceinline__ unsigned xb_add(unsigned* p, unsigned v) { return __hip_atomic_fetch_add(p, v, __ATOMIC_RELAXED, __HIP_MEMORY_SCOPE_AGENT); }
__device__ __forceinline__ unsigned xb_xcc_id() { return (unsigned)__builtin_amdgcn_s_getreg((3 << 11) | 20) & 0xFu; }
#define XB_SPIN(cond, bar) do { unsigned _sp = 0; while (cond) { __builtin_amdgcn_s_sleep(1); \
    if ((++_sp & 255u) == 0u) { if (xb_ld(&(bar)[XB_TMO])) break; if (_sp > XB_SPIN_CAP) { atomicAdd(&(bar)[XB_TMO], 1u); break; } } } } while (0)
struct XcdBarrier { unsigned* bar; unsigned x; volatile LAS unsigned* st; };
__device__ __forceinline__ XcdBarrier xcd_barrier_post(unsigned* bar, volatile LAS unsigned* st) {
    XcdBarrier b; b.bar = bar; b.x = xb_xcc_id(); b.st = st;
    if (threadIdx.x == 0) (void)xb_add(&bar[XB_XCNT(b.x)], 1u);
    return b;
}
__device__ __forceinline__ void xcd_barrier_complete(unsigned* bar, unsigned x, unsigned& nloc, unsigned& nx) {
    const unsigned G = gridDim.x * gridDim.y * gridDim.z;
    unsigned sum, cnt, mine, sp = 0u;
    for (;;) {
        sum = 0u; cnt = 0u; mine = 0u;
#pragma unroll
        for (unsigned j = 0; j < 16; ++j) { const unsigned c = xb_ld(&bar[XB_XCNT(j)]); sum += c; cnt += (c > 0u) ? 1u : 0u; mine = (j == x) ? c : mine; }
        if (sum == G) break;
        __builtin_amdgcn_s_sleep(1);
        if ((++sp & 255u) == 0u) { if (xb_ld(&bar[XB_TMO])) break; if (sp > XB_SPIN_CAP) { atomicAdd(&bar[XB_TMO], 1u); break; } }
    }
    nloc = mine > 0u ? mine : 1u; nx = cnt > 0u ? cnt : 1u;
}
__device__ __forceinline__ void xcd_barrier(const XcdBarrier& b) {
    asm volatile("s_waitcnt vmcnt(0)" ::: "memory");
    __syncthreads();
    if (threadIdx.x == 0) {
        unsigned* bar = b.bar;
        __builtin_amdgcn_s_waitcnt(0);
        unsigned nloc = b.st[0], nx = b.st[1];
        if (nloc == 0u) { xcd_barrier_complete(bar, b.x, nloc, nx); b.st[0] = nloc; b.st[1] = nx; }
        const unsigned old = xb_add(&bar[XB_XSUB(b.x)], 1u);
        const unsigned gen = old / nloc;
        if (old + 1u == (gen + 1u) * nloc) {
            __builtin_amdgcn_fence(__ATOMIC_RELEASE, "agent");
            asm volatile("s_waitcnt vmcnt(0)" ::: "memory");
            const unsigned og = xb_add(&bar[XB_TOP], 1u);
            const unsigned tg = og / nx;
            if (og + 1u == (tg + 1u) * nx) xb_add(&bar[XB_TOPGEN], 1u);
            else XB_SPIN(xb_ld(&bar[XB_TOPGEN]) == tg, bar);
            __builtin_amdgcn_fence(__ATOMIC_ACQUIRE, "agent");
            xb_add(&bar[XB_XGEN(b.x)], 1u);
            asm volatile("s_waitcnt vmcnt(0)" ::: "memory");
        } else {
            XB_SPIN(xb_ld(&bar[XB_XGEN(b.x)]) == gen, bar);
            __builtin_amdgcn_fence(__ATOMIC_ACQUIRE, "agent");
            asm volatile("s_waitcnt vmcnt(0)" ::: "memory");
        }
    }
    __syncthreads();
}

#ifndef DUP
#define DUP 0
#endif
#define REP(bit) for (int rep_ = 0; rep_ < (((DUP) >> (bit)) & 1) + 1; ++rep_)
#define GSYNC() do { XcdBarrier xb_; xb_.bar = (unsigned*)(a.ws + OFF_CTL); xb_.x = xb_xcc_id(); xb_.st = (volatile LAS unsigned*)(lds + 131072 + 4096 - 16); xcd_barrier(xb_); if ((DUP) & 1) xcd_barrier(xb_); } while (0)
__global__ void __launch_bounds__(512, 2) fwd_megakernel(KArgs a) {
    extern __shared__ __attribute__((aligned(16))) unsigned char lds_raw[];
    LAS unsigned char* lds = (LAS unsigned char*)lds_raw;
    cg::grid_group grid = cg::this_grid();
    if (threadIdx.x < 4) ((volatile LAS unsigned*)(lds + 131072 + 4096 - 16))[threadIdx.x] = 0u;
    __syncthreads();
    (void)xcd_barrier_post((unsigned*)(a.ws + OFF_CTL), (volatile LAS unsigned*)(lds + 131072 + 4096 - 16));
    const int G = gridDim.x, NGW = G * 8;
    unsigned char* ws = a.ws;
    const float* MOD = (const float*)(ws + OFF_MOD);

    { const int tid0 = opaque_tid(), lane = tid0 & 63, wave = __builtin_amdgcn_readfirstlane(tid0 >> 6), gw = blockIdx.x * 8 + wave;
      REP(1) p0_prologue(a, lds, gw, NGW, wave, lane); }
    if (a.ws == nullptr) grid.sync();
    GSYNC();
    p0_mod_reduce(a);
    { const int tid0 = opaque_tid(), lane = tid0 & 63, wave = __builtin_amdgcn_readfirstlane(tid0 >> 6); p0_toeplitz(a, opaque_bid() * 8 + wave, NGW, lane); }
    GSYNC();

    for (int l = 0; l < NL; ++l) {
        const float* modl = MOD + (size_t)l * 5 * 6144;
        { const int t_ = opaque_tid(), lane = t_ & 63, wave = __builtin_amdgcn_readfirstlane(t_ >> 6); REP(6) norm_phase(a, l, l == 0, a.in[10] + l * 1024, modl, 0, 1024, opaque_bid() * 8 + wave, NGW, lane); }
        GSYNC();
        {
            pg8::SchedSimple S; S.init(ws + OFF_H, ws + OFF_WIN + (size_t)l * INC * 1024 * 2, MROWS, INC, 1024, G, opaque_bid());
            EpiIn E{(bf16_t*)(ws + OFF_CB), (bf16_t*)(ws + OFF_PCX), (bf16_t*)(ws + OFF_Q), (bf16_t*)(ws + OFF_K), (bf16_t*)(ws + OFF_V), (bf16_t*)(ws + OFF_U), (bf16_t*)(ws + OFF_G), a.out,
                    a.in[14] + l * 64, a.in[15] + l * 64, (const f32x2*)(ws + OFF_ROPE), l};
            REP(4) pg8::gemm_phase(lds, 1024, S, E);
        }
        GSYNC();
        { const int t_ = opaque_tid(), lane = t_ & 63, wave = __builtin_amdgcn_readfirstlane(t_ >> 6); REP(2) ssm_phase(a, lds, l, wave, lane); }
        GSYNC();
        REP(3) for (int u = opaque_bid(); u < 512; u += G) attn_unit(a, lds, l, u);
        {
            pg8::SchedSimple S; S.init(ws + OFF_YG, ws + OFF_WGLU + (size_t)l * 512 * 512 * 2, MROWS, 512, 512, G, opaque_bid());
            EpiGlu E{(const bf16_t*)(ws + OFF_YG), (bf16_t*)(ws + OFF_U), a.in[25] + l * 512};
            pg8::gemm_phase(lds, 512, S, E);
        }
        { const int bid = opaque_bid(); if (G >= 256) { if (bid >= 128) conv_phase(a, l, bid - 128, G - 128); } else conv_phase(a, l, bid, G); }
        GSYNC();
        {
            pg8::SchedProj S; S.o.init(MROWS, 1024, G, opaque_bid()); S.tstep = (size_t)256 * 512 * 2;
            S.A0 = (const char*)(ws + OFF_CB); S.A1 = (const char*)(ws + OFF_YA); S.A2 = (const char*)(ws + OFF_YA + (size_t)MROWS * 512 * 2); S.A3 = (const char*)(ws + OFF_U);
            S.B = (const char*)(ws + OFF_WPROJ + (size_t)l * 4096 * 512 * 2);
            EpiProj E{(const bf16_t*)(ws + OFF_G), (bf16_t*)(ws + OFF_Q)};
            REP(7) pg8::gemm_phase(lds, 512, S, E);
        }
        GSYNC();
        {
            pg8::SchedSimple S; S.init(ws + OFF_Q, ws + OFF_WOUT + (size_t)l * 1024 * 1024 * 2, MROWS, 1024, 1024, G, opaque_bid());
            EpiRes E{a.out, modl + 2048};
            pg8::gemm_phase(lds, 1024, S, E);
        }
        GSYNC();
        { const int t_ = opaque_tid(), lane = t_ & 63, wave = __builtin_amdgcn_readfirstlane(t_ >> 6); norm_phase(a, l, false, a.in[30] + l * 1024, modl, 3072, 4096, opaque_bid() * 8 + wave, NGW, lane); }
        GSYNC();
        {
            pg8::SchedSimple S; S.init(ws + OFF_H, ws + OFF_WGU + (size_t)l * 5632 * 1024 * 2, MROWS, 5632, 1024, G, opaque_bid());
            EpiFfn1 E{(bf16_t*)(ws + OFF_G)};
            REP(5) pg8::gemm_phase(lds, 1024, S, E);
        }
        GSYNC();
        {
            pg8::SchedSimple S; S.init(ws + OFF_G, ws + OFF_WDN + (size_t)l * 1024 * FF * 2, MROWS, 1024, FF, G, opaque_bid());
            EpiRes E{a.out, modl + 5120};
            pg8::gemm_phase(lds, FF, S, E);
        }
        GSYNC();
    }
    { const int tid0 = opaque_tid(), lane = tid0 & 63, wave = __builtin_amdgcn_readfirstlane(tid0 >> 6), gw = blockIdx.x * 8 + wave;
      final_norm_phase(a, gw, NGW, lane); }
}

extern "C" void kernel_launch(void* const* d_in, const int* in_sizes, int n_in, void* d_out, int out_size, void* d_ws, size_t ws_size, hipStream_t stream) {
    static int grid = 0;
    if (grid == 0) {
        if (n_in != 35 || ws_size < WS_END) { fprintf(stderr, "kernel_launch: n_in %d ws %zu (need %zu)\n", n_in, ws_size, (size_t)WS_END); grid = -1; return; }
        int dev = 0, cus = 0, per_cu = 0;
        hipGetDevice(&dev); hipDeviceGetAttribute(&cus, hipDeviceAttributeMultiprocessorCount, dev);
        hipFuncSetAttribute((const void*)fwd_megakernel, hipFuncAttributeMaxDynamicSharedMemorySize, LDS_BYTES);
        hipOccupancyMaxActiveBlocksPerMultiprocessor(&per_cu, (const void*)fwd_megakernel, 512, LDS_BYTES);
        if (per_cu < 1) { fprintf(stderr, "kernel_launch: occupancy %d\n", per_cu); per_cu = 1; }
        grid = cus;
        (void)hipGetLastError();
    }
    if (grid < 0) return;
    if (hipMemsetAsync((char*)d_ws + OFF_CTL, 0, 16384, stream) != hipSuccess) { fprintf(stderr, "kernel_launch: memset failed\n"); return; }
    KArgs a{};
    for (int i = 0; i < 35; ++i) a.in[i] = (const float*)d_in[i];
    a.out = (float*)d_out; a.ws = (unsigned char*)d_ws;
    void* args[] = {&a};
    hipError_t e = hipLaunchCooperativeKernel((const void*)fwd_megakernel, dim3(grid), dim3(512), args, LDS_BYTES, stream);
    if (e != hipSuccess) fprintf(stderr, "cooperative launch failed: %s (grid %d)\n", hipGetErrorString(e), grid);
}
```

```cpp
#include <hip/hip_runtime.h>
#include <hip/hip_cooperative_groups.h>
#include <cstdint>
#include <cstdio>
namespace cg = cooperative_groups;

#define LAS __attribute__((address_space(3)))
typedef unsigned short bf16_t;
typedef short bf16x8 __attribute__((ext_vector_type(8)));
typedef short s16x4 __attribute__((ext_vector_type(4)));
typedef float f32x4 __attribute__((ext_vector_type(4)));
typedef float f32x2 __attribute__((ext_vector_type(2)));
typedef float f32x16 __attribute__((ext_vector_type(16)));
typedef unsigned u32x4 __attribute__((ext_vector_type(4)));
typedef unsigned u32x2 __attribute__((ext_vector_type(2)));

constexpr int MROWS = 16384, DM = 1024, INC = 6656, FF = 2816, NL = 4;
constexpr int PROMPT_ROWS = 8192;
constexpr float RMS_EPS = 1e-6f;
constexpr float QSCALE = 0.125f * 1.4426950408889634f;
constexpr size_t OUT_CK = 16777216, OUT_CV = 25165824, OUT_SR = 33554432, OUT_SI = 34078720;
constexpr size_t OFF_WIN = 0;
constexpr size_t OFF_WPROJ = OFF_WIN + (size_t)NL * INC * 1024 * 2;
constexpr size_t OFF_WOUT = OFF_WPROJ + (size_t)NL * 4 * 1024 * 512 * 2;
constexpr size_t OFF_WGLU = OFF_WOUT + (size_t)NL * 1024 * 1024 * 2;
constexpr size_t OFF_WGU = OFF_WGLU + (size_t)NL * 512 * 512 * 2;
constexpr size_t OFF_WDN = OFF_WGU + (size_t)NL * 5632 * 1024 * 2;
constexpr size_t OFF_MODP = OFF_WDN + (size_t)NL * 1024 * FF * 2;
constexpr size_t OFF_MOD = OFF_MODP + (size_t)16 * NL * 5 * 6144 * 4;
constexpr size_t OFF_SSA = OFF_MOD + (size_t)NL * 5 * 6144 * 4;
constexpr size_t OFF_BBF = OFF_SSA + (size_t)256 * 64 * 8;
constexpr size_t OFF_CCF = OFF_BBF + (size_t)256 * 8 * 1024;
constexpr size_t OFF_PW = OFF_CCF + (size_t)256 * 4 * 1024;
constexpr size_t OFF_TF = OFF_PW + (size_t)256 * 17 * 64 * 8;
constexpr size_t OFF_BBR = OFF_TF + (size_t)256 * 16 * 1024;
constexpr size_t OFF_PW16 = OFF_BBR + (size_t)256 * 64 * 16 * 8;
constexpr size_t OFF_ROPE = OFF_PW16 + (size_t)256 * 16 * 64 * 8;
constexpr size_t OFF_KC = OFF_ROPE + 8192;
constexpr size_t OFF_VC = OFF_KC + (size_t)4 * 4 * 256 * 256 * 2;
constexpr size_t OFF_H = OFF_VC + (size_t)4 * 4 * 256 * 256 * 2;
constexpr size_t OFF_CB = OFF_H + (size_t)MROWS * 1024 * 2;
constexpr size_t OFF_PCX = OFF_CB + (size_t)MROWS * 512 * 2;
constexpr size_t OFF_Q = OFF_PCX + (size_t)MROWS * 512 * 2;
constexpr size_t OFF_K = OFF_Q + (size_t)MROWS * 1024 * 2;
constexpr size_t OFF_V = OFF_K + (size_t)MROWS * 256 * 2;
constexpr size_t OFF_U = OFF_V + (size_t)MROWS * 256 * 2;
constexpr size_t OFF_G = OFF_U + (size_t)MROWS * 512 * 2;
constexpr size_t OFF_YA = OFF_G + (size_t)3 * MROWS * 1024 * 2;
constexpr size_t OFF_YG = OFF_YA + (size_t)MROWS * 1024 * 2;
constexpr size_t OFF_CTL = OFF_YG + (size_t)MROWS * 512 * 2;
constexpr size_t WS_END = OFF_CTL + 16384;

constexpr int LDS_BYTES = 131072 + 4096;

struct KArgs { const float* in[35]; float* out; unsigned char* ws; };

typedef __bf16 bf16x2_t __attribute__((ext_vector_type(2)));
__device__ __forceinline__ unsigned cvt_pk_bf16(float lo, float hi) { const f32x2 v = {lo, hi}; const bf16x2_t b = __builtin_convertvector(v, bf16x2_t); return __builtin_bit_cast(unsigned, b); }
__device__ __forceinline__ float bflo(unsigned w) { return __uint_as_float(w << 16); }
__device__ __forceinline__ float bfhi(unsigned w) { return __uint_as_float(w & 0xffff0000u); }
__device__ __forceinline__ float fsigmoid(float x) { return __builtin_amdgcn_rcpf(1.0f + __expf(-x)); }
__device__ __forceinline__ int opaque_tid() { int t = threadIdx.x; asm volatile("" : "+v"(t)); return t; }
__device__ __forceinline__ int opaque_bid() { int b = blockIdx.x; asm volatile("" : "+s"(b)); return b; }
__device__ __forceinline__ float wave_sum(float v) {
#pragma unroll
    for (int o = 1; o < 64; o <<= 1) v += __shfl_xor(v, o);
    return v;
}
__device__ __forceinline__ u32x4 pack8(f32x4 a, f32x4 b) { u32x4 w; w.x = cvt_pk_bf16(a[0], a[1]); w.y = cvt_pk_bf16(a[2], a[3]); w.z = cvt_pk_bf16(b[0], b[1]); w.w = cvt_pk_bf16(b[2], b[3]); return w; }
__device__ __forceinline__ void dsincos(double x, double& s, double& c) {
    const double k = __builtin_rint(x * 0.63661977236758134308);
    const double r = (x - k * 1.57079632679489655800) - k * 6.12323399573676603587e-17;
    const double r2 = r * r;
    double sp = -1.0 / 1307674368000.0; sp = sp * r2 + 1.0 / 6227020800.0; sp = sp * r2 - 1.0 / 39916800.0; sp = sp * r2 + 1.0 / 362880.0; sp = sp * r2 - 1.0 / 5040.0; sp = sp * r2 + 1.0 / 120.0; sp = sp * r2 - 1.0 / 6.0; sp = sp * r2 + 1.0; sp *= r;
    double cp = 1.0 / 20922789888000.0; cp = cp * r2 - 1.0 / 87178291200.0; cp = cp * r2 + 1.0 / 479001600.0; cp = cp * r2 - 1.0 / 3628800.0; cp = cp * r2 + 1.0 / 40320.0; cp = cp * r2 - 1.0 / 720.0; cp = cp * r2 + 1.0 / 24.0; cp = cp * r2 - 0.5; cp = cp * r2 + 1.0;
    const int q = ((int)k) & 3;
    s = (q == 0) ? sp : (q == 1) ? cp : (q == 2) ? -sp : -cp;
    c = (q == 0) ? cp : (q == 1) ? -sp : (q == 2) ? -cp : sp;
}

namespace pg8 {
constexpr int BM = 256, BK = 64, HALF = 128, HTB = HALF * BK * 2, NXCD = 8, WGM = 8;
__device__ __forceinline__ int lds_byte(int r, int c) { const int st = (r >> 4) * 2 + (c >> 5), rr = r & 15, cc = c & 31, ob = rr * 64 + cc * 2; return st * 1024 + (ob ^ (((ob >> 9) & 1) << 5)); }
__device__ __forceinline__ void stage_rc(int b, int& R, int& C) { const int st = b / 1024, sb = b % 1024, swz = sb ^ (((sb >> 9) & 1) << 5); R = (st >> 1) * 16 + swz / 64; C = (st & 1) * 32 + (swz % 64) / 2; }

struct Unit { int pm, pn, seg; const char* A; const char* B; };
struct TileOrder {
    int nM, nN, nwg, G, c;
    __device__ void init(int M, int N, int G_, int c_) { nM = M / BM; nN = N / BM; nwg = nM * nN; G = G_; c = c_; }
    __device__ bool tile(long L, int& pm, int& pn) const {
        if (L >= nwg) return false;
        int wgid = (int)L; { const int q = nwg / NXCD, r = nwg % NXCD, xcd = wgid % NXCD, off = wgid / NXCD; wgid = (xcd < r ? xcd * (q + 1) : r * (q + 1) + (xcd - r) * q) + off; }
        const int nig = WGM * nN, gid = wgid / nig, fm = gid * WGM, gsz = (nM - fm) < WGM ? (nM - fm) : WGM;
        pm = fm + ((wgid % nig) % gsz); pn = (wgid % nig) / gsz; return true;
    }
};
struct SchedSimple {
    TileOrder o; const char* A; const char* B; size_t tstep;
    __device__ void init(const void* A_, const void* B_, int M, int N, int K, int G, int c) { o.init(M, N, G, c); A = (const char*)A_; B = (const char*)B_; tstep = (size_t)BM * K * 2; }
    __device__ bool next(int i, Unit& u) const { int pm, pn; if (!o.tile((long)i * o.G + o.c, pm, pn)) return false; u.pm = pm; u.pn = pn; u.seg = 0; u.A = A + (size_t)pm * tstep; u.B = B + (size_t)pn * tstep; return true; }
};
struct SchedProj {
    TileOrder o; const char *A0, *A1, *A2, *A3; const char* B; size_t tstep;
    __device__ bool next(int i, Unit& u) const { int pm, pn; if (!o.tile((long)(i >> 2) * o.G + o.c, pm, pn)) return false; const int seg = i & 3; u.pm = pm; u.pn = pn; u.seg = seg;
        const char* a = seg == 0 ? A0 : seg == 1 ? A1 : seg == 2 ? A2 : A3; u.A = a + (size_t)pm * tstep; u.B = B + (size_t)seg * (1024 * 512 * 2) + (size_t)pn * tstep; return true; }
};

template <class Epi, class Sched>
__device__ __forceinline__ void gemm_phase(LAS unsigned char* lds, const int K, const Sched& S, const Epi& E) {
    int tid = threadIdx.x; asm volatile("" : "+v"(tid));
    const int wid = __builtin_amdgcn_readfirstlane(tid >> 6), lane = tid & 63, wr = wid >> 2, wc = wid & 3, fr = lane & 15, fq = lane >> 4;
    const int nt = K / BK;
    unsigned voffA[2];
#pragma unroll
    for (int i = 0; i < 2; ++i) { int R, C; stage_rc(tid * 16 + i * 8192, R, C); voffA[i] = (unsigned)(R * K + C) * 2u; }
    const size_t kstep = (size_t)(BK * 2);
    const size_t hstep = (size_t)HALF * K * 2;
    const unsigned ldsw = (unsigned)wid * 1024u;
    const int aoff = lds_byte(wr * 64 + fr, fq * 8), boff = lds_byte(wc * 32 + fr, fq * 8);
#define PG8_SA(b, h) (((b) * 2 + (h)) * HTB)
#define PG8_SB(b, h) ((4 + (b) * 2 + (h)) * HTB)
#define PG8_STAGE(bufoff, gbase) do { _Pragma("unroll") for (int _i = 0; _i < 2; ++_i) \
        __builtin_amdgcn_global_load_lds((const unsigned*)((const char*)(gbase) + voffA[_i]), (LAS unsigned*)(lds + (bufoff) + ldsw + _i * 8192), 16, 0, 0); } while (0)
#define PG8_LDA(dst, b, h) do { _Pragma("unroll") for (int m = 0; m < 4; ++m) _Pragma("unroll") for (int k = 0; k < 2; ++k) dst[m][k] = *(const LAS bf16x8*)(lds + PG8_SA(b, h) + aoff + m * 2048 + k * 1024); } while (0)
#define PG8_LDB(dst, b, h) do { _Pragma("unroll") for (int n = 0; n < 2; ++n) _Pragma("unroll") for (int k = 0; k < 2; ++k) dst[n][k] = *(const LAS bf16x8*)(lds + PG8_SB(b, h) + boff + n * 2048 + k * 1024); } while (0)
#define PG8_MMA(ai, bj, At, Bt) do { __builtin_amdgcn_s_setprio(1); _Pragma("unroll") for (int m = 0; m < 4; ++m) _Pragma("unroll") for (int n = 0; n < 2; ++n) _Pragma("unroll") for (int k = 0; k < 2; ++k) \
        acc[ai][bj][m][n] = __builtin_amdgcn_mfma_f32_16x16x32_bf16(Bt[n][k], At[m][k], acc[ai][bj][m][n], 0, 0, 0); __builtin_amdgcn_s_setprio(0); } while (0)
#define PG8_WAIT_V(n) asm volatile("s_waitcnt vmcnt(" #n ")" ::: "memory")
#define PG8_WAIT_L(n) asm volatile("s_waitcnt lgkmcnt(" #n ")" ::: "memory")
#define PG8_BAR __builtin_amdgcn_s_barrier()
#define PG8_SCHED __builtin_amdgcn_sched_barrier(0)
    Unit cur, nxt; int ui = 0;
    if (!S.next(0, cur)) return;
    f32x4 acc[2][2][4][2];
#pragma unroll
    for (int a = 0; a < 2; ++a)
#pragma unroll
        for (int b = 0; b < 2; ++b)
#pragma unroll
            for (int m = 0; m < 4; ++m)
#pragma unroll
                for (int n = 0; n < 2; ++n) acc[a][b][m][n] = (f32x4){0.f, 0.f, 0.f, 0.f};
    bf16x8 At[4][2], B0[2][2], B1[2][2];
    const char* cA = cur.A; const char* cB = cur.B;
    PG8_STAGE(PG8_SB(0, 0), cB); PG8_STAGE(PG8_SB(0, 1), cB + hstep); PG8_STAGE(PG8_SA(0, 0), cA); PG8_STAGE(PG8_SA(0, 1), cA + hstep);
    if (wr == 1) PG8_BAR;
    PG8_WAIT_V(2); PG8_BAR;
    PG8_STAGE(PG8_SB(1, 0), cB + kstep); PG8_STAGE(PG8_SA(1, 0), cA + kstep); PG8_STAGE(PG8_SB(1, 1), cB + hstep + kstep);
    PG8_WAIT_V(6); PG8_BAR;
    for (;;) {
        const bool has_next = S.next(ui + 1, nxt);
        const char* nA = has_next ? nxt.A : cA; const char* nB = has_next ? nxt.B : cB;
        for (int t = 0; t < nt; t += 2) {
            const bool last = (t == nt - 2);
            const char* a1 = cA + (size_t)(t + 1) * kstep;
            const char* a2 = last ? nA : cA + (size_t)(t + 2) * kstep; const char* b2 = last ? nB : cB + (size_t)(t + 2) * kstep;
            const char* a3 = a2 + kstep; const char* b3 = b2 + kstep;
            PG8_LDB(B0, 0, 0); PG8_LDB(B1, 0, 1); PG8_SCHED; PG8_LDA(At, 0, 0); PG8_STAGE(PG8_SA(1, 1), a1 + hstep);
            PG8_WAIT_V(8); PG8_WAIT_L(0); PG8_BAR; PG8_MMA(0, 0, At, B0); PG8_MMA(0, 1, At, B1); PG8_BAR; PG8_SCHED;
            PG8_LDA(At, 0, 1); PG8_STAGE(PG8_SB(0, 0), b2); PG8_STAGE(PG8_SB(0, 1), b2 + hstep); PG8_STAGE(PG8_SA(0, 0), a2);
            PG8_WAIT_V(8); PG8_WAIT_L(0); PG8_BAR; PG8_MMA(1, 0, At, B0); PG8_MMA(1, 1, At, B1); PG8_BAR; PG8_SCHED;
            PG8_LDB(B0, 1, 0); PG8_LDB(B1, 1, 1); PG8_SCHED; PG8_LDA(At, 1, 0); PG8_STAGE(PG8_SA(0, 1), a2 + hstep);
            PG8_WAIT_V(8); PG8_WAIT_L(0); PG8_BAR; PG8_MMA(0, 0, At, B0); PG8_MMA(0, 1, At, B1); PG8_BAR; PG8_SCHED;
            PG8_LDA(At, 1, 1); PG8_STAGE(PG8_SB(1, 0), b3); PG8_STAGE(PG8_SB(1, 1), b3 + hstep); PG8_STAGE(PG8_SA(1, 0), a3);
            PG8_WAIT_V(8); PG8_WAIT_L(0); PG8_BAR; PG8_MMA(1, 0, At, B0); PG8_MMA(1, 1, At, B1); PG8_BAR; PG8_SCHED;
        }
        if (wr == 0) PG8_BAR;
        E(acc, cur, wr, wc, fr, fq);
        if (!has_next) break;
        if constexpr (!Epi::KEEP) {
#pragma unroll
            for (int a = 0; a < 2; ++a)
#pragma unroll
                for (int b = 0; b < 2; ++b)
#pragma unroll
                    for (int m = 0; m < 4; ++m)
#pragma unroll
                        for (int n = 0; n < 2; ++n) acc[a][b][m][n] = (f32x4){0.f, 0.f, 0.f, 0.f};
        }
        cur = nxt; cA = nA; cB = nB; ++ui;
        if (wr == 1) PG8_BAR;
    }
    PG8_WAIT_V(0);
    PG8_BAR;
#undef PG8_SA
#undef PG8_SB
#undef PG8_STAGE
#undef PG8_LDA
#undef PG8_LDB
#undef PG8_MMA
#undef PG8_WAIT_V
#undef PG8_WAIT_L
#undef PG8_BAR
#undef PG8_SCHED
}
}
using pg8::Unit;

struct EpiIn {
    static constexpr bool KEEP = false;
    bf16_t *CB, *PCX, *Q, *Kb, *Vb, *U, *G; float* out; const float *qg, *kg; const f32x2* rope; int layer;
    __device__ __forceinline__ void operator()(f32x4 (&acc)[2][2][4][2], const Unit& u, int wr, int wc, int fr, int fq) const {
        const int pn = u.pn; const int rowt = u.pm * 256 + wr * 64 + fr;
        if (pn < 2 || pn >= 11) {
            bf16_t* base; int ld, col; bool sig = false;
            if (pn < 2) { base = CB; ld = 512; col = 256 * pn + 64 * wc + 16 * fq; }
            else if (pn == 11) { base = Vb; ld = 256; col = 64 * wc + 16 * fq; }
            else if (pn < 14) { base = U; ld = 512; col = 256 * (pn - 12) + 64 * wc + 16 * fq; }
            else { const int gi = (pn - 14) >> 2; base = G + (size_t)gi * MROWS * 1024; ld = 1024; col = 256 * ((pn - 14) & 3) + 64 * wc + 16 * fq; sig = true; }
#pragma unroll
            for (int ai = 0; ai < 2; ++ai)
#pragma unroll
                for (int m = 0; m < 4; ++m) {
                    const int row = rowt + 128 * ai + 16 * m;
                    f32x4 v0 = acc[ai][0][m][0], v1 = acc[ai][0][m][1], v2 = acc[ai][1][m][0], v3 = acc[ai][1][m][1];
                    if (sig) {
#pragma unroll
                        for (int i = 0; i < 4; ++i) { v0[i] = fsigmoid(fminf(fmaxf(v0[i], -30.f), 30.f)); v1[i] = fsigmoid(fminf(fmaxf(v1[i], -30.f), 30.f)); v2[i] = fsigmoid(fminf(fmaxf(v2[i], -30.f), 30.f)); v3[i] = fsigmoid(fminf(fmaxf(v3[i], -30.f), 30.f)); }
                    }
                    bf16_t* p = base + (size_t)row * ld + col;
                    *(u32x4*)p = pack8(v0, v1); *(u32x4*)(p + 8) = pack8(v2, v3);
                    if (pn == 11 && row < PROMPT_ROWS) {
                        float* o = out + OUT_CV + ((size_t)((row >> 8) * 4 + layer) * 256 + (row & 255)) * 256 + col;
                        *(f32x4*)o = v0; *(f32x4*)(o + 4) = v1; *(f32x4*)(o + 8) = v2; *(f32x4*)(o + 12) = v3;
                    }
                }
        } else if (pn < 6) {
            const int ch = 128 * (pn - 2) + 32 * wc + 8 * fq;
#pragma unroll
            for (int ai = 0; ai < 2; ++ai)
#pragma unroll
                for (int m = 0; m < 4; ++m) {
                    const int row = rowt + 128 * ai + 16 * m;
                    *(u32x4*)(PCX + (size_t)row * 512 + ch) = pack8(acc[ai][0][m][0] * acc[ai][1][m][0], acc[ai][0][m][1] * acc[ai][1][m][1]);
                }
        } else {
            const bool isq = pn < 10;
            const int half = fq >> 1, sub = fq & 1, d1 = 32 * half + 8 * sub;
            const float* gsrc = isq ? qg : kg;
            const f32x4 g1a = *(const f32x4*)(gsrc + d1), g1b = *(const f32x4*)(gsrc + d1 + 4), g2a = *(const f32x4*)(gsrc + d1 + 16), g2b = *(const f32x4*)(gsrc + d1 + 20);
#pragma unroll
            for (int ai = 0; ai < 2; ++ai)
#pragma unroll
                for (int m = 0; m < 4; ++m) {
                    const int row = rowt + 128 * ai + 16 * m;
                    f32x4 x1a = acc[ai][0][m][0], x1b = acc[ai][0][m][1], x2a = acc[ai][1][m][0], x2b = acc[ai][1][m][1];
                    float ss = 0.f;
#pragma unroll
                    for (int i = 0; i < 4; ++i) ss += x1a[i] * x1a[i] + x1b[i] * x1b[i] + x2a[i] * x2a[i] + x2b[i] * x2b[i];
                    ss += __shfl_xor(ss, 16); ss += __shfl_xor(ss, 32);
                    const float rstd = rsqrtf(ss * (1.0f / 64.0f) + RMS_EPS);
                    x1a = x1a * rstd * g1a; x1b = x1b * rstd * g1b; x2a = x2a * rstd * g2a; x2b = x2b * rstd * g2b;
                    if (!isq && row < PROMPT_ROWS) {
                        float* o = out + OUT_CK + ((size_t)((row >> 8) * 4 + layer) * 256 + (row & 255)) * 256 + 64 * wc + d1;
                        *(f32x4*)o = x1a; *(f32x4*)(o + 4) = x1b; *(f32x4*)(o + 16) = x2a; *(f32x4*)(o + 20) = x2b;
                    }
                    if (row >= PROMPT_ROWS) {
                        const int t = (row - PROMPT_ROWS) & 2047; const int pos = half ? (t & 63) : (t >> 6);
                        const f32x4* rp = (const f32x4*)(rope + pos * 16 + 8 * sub);
                        const f32x4 r0 = rp[0], r1 = rp[1], r2 = rp[2], r3 = rp[3];
                        f32x4 y1a, y1b, y2a, y2b;
                        y1a[0] = x1a[0] * r0[0] - x2a[0] * r0[1]; y2a[0] = x1a[0] * r0[1] + x2a[0] * r0[0];
                        y1a[1] = x1a[1] * r0[2] - x2a[1] * r0[3]; y2a[1] = x1a[1] * r0[3] + x2a[1] * r0[2];
                        y1a[2] = x1a[2] * r1[0] - x2a[2] * r1[1]; y2a[2] = x1a[2] * r1[1] + x2a[2] * r1[0];
                        y1a[3] = x1a[3] * r1[2] - x2a[3] * r1[3]; y2a[3] = x1a[3] * r1[3] + x2a[3] * r1[2];
                        y1b[0] = x1b[0] * r2[0] - x2b[0] * r2[1]; y2b[0] = x1b[0] * r2[1] + x2b[0] * r2[0];
                        y1b[1] = x1b[1] * r2[2] - x2b[1] * r2[3]; y2b[1] = x1b[1] * r2[3] + x2b[1] * r2[2];
                        y1b[2] = x1b[2] * r3[0] - x2b[2] * r3[1]; y2b[2] = x1b[2] * r3[1] + x2b[2] * r3[0];
                        y1b[3] = x1b[3] * r3[2] - x2b[3] * r3[3]; y2b[3] = x1b[3] * r3[3] + x2b[3] * r3[2];
                        x1a = y1a; x1b = y1b; x2a = y2a; x2b = y2b;
                    }
                    bf16_t* p;
                    if (isq) { x1a = x1a * QSCALE; x1b = x1b * QSCALE; x2a = x2a * QSCALE; x2b = x2b * QSCALE; p = Q + (size_t)row * 1024 + (4 * (pn - 6) + wc) * 64 + d1; }
                    else p = Kb + (size_t)row * 256 + wc * 64 + d1;
                    *(u32x4*)p = pack8(x1a, x1b); *(u32x4*)(p + 16) = pack8(x2a, x2b);
                }
        }
    }
};

__device__ __forceinline__ void unpack16(const bf16_t* p, f32x4& a, f32x4& b, f32x4& c, f32x4& d) {
    const u32x4 w0 = *(const u32x4*)p, w1 = *(const u32x4*)(p + 8);
    a = (f32x4){bflo(w0.x), bfhi(w0.x), bflo(w0.y), bfhi(w0.y)}; b = (f32x4){bflo(w0.z), bfhi(w0.z), bflo(w0.w), bfhi(w0.w)};
    c = (f32x4){bflo(w1.x), bfhi(w1.x), bflo(w1.y), bfhi(w1.y)}; d = (f32x4){bflo(w1.z), bfhi(w1.z), bflo(w1.w), bfhi(w1.w)};
}
__device__ __forceinline__ f32x4 rcp4(f32x4 v) { return (f32x4){__builtin_amdgcn_rcpf(v[0]), __builtin_amdgcn_rcpf(v[1]), __builtin_amdgcn_rcpf(v[2]), __builtin_amdgcn_rcpf(v[3])}; }

struct EpiProj {
    static constexpr bool KEEP = true;
    const bf16_t* G; bf16_t* MG;
    __device__ __forceinline__ void operator()(f32x4 (&acc)[2][2][4][2], const Unit& u, int wr, int wc, int fr, int fq) const {
        const int seg = u.seg; if (seg == 1) return;
        const int rowt = u.pm * 256 + wr * 64 + fr, col = 256 * u.pn + 64 * wc + 16 * fq;
        const bf16_t* Gc = G; const bf16_t* Ga = G + (size_t)MROWS * 1024; const bf16_t* Gs = G + (size_t)2 * MROWS * 1024;
#pragma unroll
        for (int ai = 0; ai < 2; ++ai)
#pragma unroll
            for (int m = 0; m < 4; ++m) {
                const size_t off = (size_t)(rowt + 128 * ai + 16 * m) * 1024 + col;
                f32x4 f0, f1, f2, f3;
                if (seg == 3) { unpack16(Gs + off, f0, f1, f2, f3); }
                else {
                    f32x4 n0, n1, n2, n3, d0, d1, d2, d3;
                    unpack16((seg == 0 ? Gc : Ga) + off, n0, n1, n2, n3); unpack16((seg == 0 ? Ga : Gs) + off, d0, d1, d2, d3);
                    f0 = n0 * rcp4(d0); f1 = n1 * rcp4(d1); f2 = n2 * rcp4(d2); f3 = n3 * rcp4(d3);
                }
                acc[ai][0][m][0] *= f0; acc[ai][0][m][1] *= f1; acc[ai][1][m][0] *= f2; acc[ai][1][m][1] *= f3;
                if (seg == 3) {
                    bf16_t* p = MG + off;
                    *(u32x4*)p = pack8(acc[ai][0][m][0], acc[ai][0][m][1]); *(u32x4*)(p + 8) = pack8(acc[ai][1][m][0], acc[ai][1][m][1]);
                    acc[ai][0][m][0] = (f32x4){0.f, 0.f, 0.f, 0.f}; acc[ai][0][m][1] = (f32x4){0.f, 0.f, 0.f, 0.f}; acc[ai][1][m][0] = (f32x4){0.f, 0.f, 0.f, 0.f}; acc[ai][1][m][1] = (f32x4){0.f, 0.f, 0.f, 0.f};
                }
            }
    }
};
constexpr int XP = 2048;
struct EpiRes {
    static constexpr bool KEEP = false;
    bf16_t* X; const float* gate;
    __device__ __forceinline__ void operator()(f32x4 (&acc)[2][2][4][2], const Unit& u, int wr, int wc, int fr, int fq) const {
        const int rowt = u.pm * 256 + wr * 64 + fr, col = 256 * u.pn + 64 * wc + 16 * fq;
        const int cond = u.pm < 32 ? 0 : 1 + ((u.pm - 32) >> 3);
        const float* gp = gate + cond * 6144 + col;
        const f32x4 g0 = *(const f32x4*)gp, g1 = *(const f32x4*)(gp + 4), g2 = *(const f32x4*)(gp + 8), g3 = *(const f32x4*)(gp + 12);
#pragma unroll
        for (int ai = 0; ai < 2; ++ai)
#pragma unroll
            for (int m = 0; m < 4; ++m) {
                bf16_t* p = X + (size_t)(rowt + 128 * ai + 16 * m) * XP + col;
                f32x4 x0, x1, x2, x3; unpack16(p, x0, x1, x2, x3);
                x0 += g0 * acc[ai][0][m][0]; x1 += g1 * acc[ai][0][m][1]; x2 += g2 * acc[ai][1][m][0]; x3 += g3 * acc[ai][1][m][1];
                *(u32x4*)p = pack8(x0, x1); *(u32x4*)(p + 8) = pack8(x2, x3);
            }
    }
};
struct EpiGlu {
    static constexpr bool KEEP = false;
    const bf16_t* YG; bf16_t* YS; const float* bias;
    __device__ __forceinline__ void operator()(f32x4 (&acc)[2][2][4][2], const Unit& u, int wr, int wc, int fr, int fq) const {
        const int rowt = u.pm * 256 + wr * 64 + fr, col = 256 * u.pn + 64 * wc + 16 * fq;
        const f32x4 b0 = *(const f32x4*)(bias + col), b1 = *(const f32x4*)(bias + col + 4), b2 = *(const f32x4*)(bias + col + 8), b3 = *(const f32x4*)(bias + col + 12);
#pragma unroll
        for (int ai = 0; ai < 2; ++ai)
#pragma unroll
            for (int m = 0; m < 4; ++m) {
                const size_t off = (size_t)(rowt + 128 * ai + 16 * m) * 512 + col;
                f32x4 y0, y1, y2, y3; unpack16(YG + off, y0, y1, y2, y3);
                f32x4 s0 = acc[ai][0][m][0] + b0, s1 = acc[ai][0][m][1] + b1, s2 = acc[ai][1][m][0] + b2, s3 = acc[ai][1][m][1] + b3;
#pragma unroll
                for (int i = 0; i < 4; ++i) { y0[i] *= fsigmoid(s0[i]); y1[i] *= fsigmoid(s1[i]); y2[i] *= fsigmoid(s2[i]); y3[i] *= fsigmoid(s3[i]); }
                *(u32x4*)(YS + off) = pack8(y0, y1); *(u32x4*)(YS + off + 8) = pack8(y2, y3);
            }
    }
};
struct EpiFfn1 {
    static constexpr bool KEEP = false;
    bf16_t* ACT;
    __device__ __forceinline__ void operator()(f32x4 (&acc)[2][2][4][2], const Unit& u, int wr, int wc, int fr, int fq) const {
        const int rowt = u.pm * 256 + wr * 64 + fr, ch = 128 * u.pn + 32 * wc + 8 * fq;
#pragma unroll
        for (int ai = 0; ai < 2; ++ai)
#pragma unroll
            for (int m = 0; m < 4; ++m) {
                f32x4 a = acc[ai][0][m][0], b = acc[ai][0][m][1];
#pragma unroll
                for (int i = 0; i < 4; ++i) { a[i] = a[i] * fsigmoid(a[i]) * acc[ai][1][m][0][i]; b[i] = b[i] * fsigmoid(b[i]) * acc[ai][1][m][1][i]; }
                *(u32x4*)(ACT + (size_t)(rowt + 128 * ai + 16 * m) * FF + ch) = pack8(a, b);
            }
    }
};

struct WSrc { const float* p; int ld; };
__device__ __forceinline__ int gen_col(int cp) { const int bj = cp >> 7, wc = (cp >> 5) & 3, n = (cp >> 4) & 1, fq = (cp >> 2) & 3, i = cp & 3; return 64 * wc + 16 * fq + 8 * bj + 4 * n + i; }
__device__ __forceinline__ WSrc wsrc(const KArgs& a, int mat, int l, int d) {
    const int pn = d >> 8, cp = d & 255; const int bj = cp >> 7, wc = (cp >> 5) & 3, n = (cp >> 4) & 1, fq = (cp >> 2) & 3, i = cp & 3;
    WSrc s;
    if (mat == 0) {
        int col;
        if (pn >= 2 && pn < 6) col = (bj ? 1024 : 512) + 128 * (pn - 2) + 32 * wc + 8 * fq + 4 * n + i;
        else if (pn >= 6 && pn < 11) col = 256 * pn + 64 * wc + 32 * (fq >> 1) + 16 * bj + 8 * (fq & 1) + 4 * n + i;
        else col = 256 * pn + gen_col(cp);
        s.p = a.in[11] + (size_t)l * 1024 * INC + col; s.ld = INC;
    } else if (mat == 1) {
        const int seg = d >> 10, dd = d & 1023; const int col = 256 * (dd >> 8) + gen_col(cp);
        const float* b = seg == 0 ? a.in[26] + (size_t)l * 512 * 1024 : seg == 1 ? a.in[27] + (size_t)l * 1024 * 1024 : seg == 2 ? a.in[27] + (size_t)l * 1024 * 1024 + 512 * 1024 : a.in[28] + (size_t)l * 512 * 1024;
        s.p = b + col; s.ld = 1024;
    } else if (mat == 2) { s.p = a.in[29] + (size_t)l * 1024 * 1024 + 256 * pn + gen_col(cp); s.ld = 1024; }
    else if (mat == 3) { s.p = a.in[24] + (size_t)l * 512 * 512 + 256 * pn + gen_col(cp); s.ld = 512; }
    else if (mat == 4) { const int ch = 128 * pn + 32 * wc + 8 * fq + 4 * n + i; s.p = (bj ? a.in[32] : a.in[31]) + (size_t)l * 1024 * FF + ch; s.ld = FF; }
    else { s.p = a.in[33] + (size_t)l * FF * 1024 + 256 * pn + gen_col(cp); s.ld = 1024; }
    return s;
}
__device__ __forceinline__ void transpose_item(const KArgs& a, int mat, int l, int K, bf16_t* WT, LAS float* scr, int item, int lane) {
    const int nkb = K / 64, kb = item % nkb, nb = item / nkb, k0 = 64 * kb, d0 = 32 * nb;
    const WSrc s = wsrc(a, mat, l, d0 + (lane & 31));
    const float* sp = s.p + (size_t)(k0 + (lane >> 5)) * s.ld;
#pragma unroll 8
    for (int i = 0; i < 32; ++i) scr[(2 * i + (lane >> 5)) * 33 + (lane & 31)] = sp[(size_t)(2 * i) * s.ld];
    asm volatile("s_waitcnt lgkmcnt(0)" ::: "memory");
    const int c = lane & 7;
#pragma unroll
    for (int j = 0; j < 4; ++j) { const int n = (lane >> 3) + 8 * j; const LAS float* q = scr + (8 * c) * 33 + n;
        u32x4 o; o.x = cvt_pk_bf16(q[0 * 33], q[1 * 33]); o.y = cvt_pk_bf16(q[2 * 33], q[3 * 33]); o.z = cvt_pk_bf16(q[4 * 33], q[5 * 33]); o.w = cvt_pk_bf16(q[6 * 33], q[7 * 33]);
        *(u32x4*)(WT + (size_t)(d0 + n) * K + k0 + 8 * c) = o; }
    asm volatile("s_waitcnt lgkmcnt(0)" ::: "memory");
}

__device__ __forceinline__ void p0_prologue(const KArgs& a, LAS unsigned char* lds, int gw, int NGW, int wave, int lane) {
    unsigned char* ws = a.ws;
    LAS float* scond = (LAS float*)(lds + 69632);
    for (int i = opaque_tid(); i < 5 * 1024; i += 512) { const float v = i < 1024 ? a.in[7][i] : a.in[2][i - 1024]; scond[i] = v * fsigmoid(v); }
    __syncthreads();
    LAS float* scr = (LAS float*)(lds + wave * 8448);
    constexpr int I0 = 16 * (INC / 32), I1 = 8 * (4096 / 32), I2 = 16 * 32, I3 = 8 * 16, I4 = 16 * (5632 / 32), I5 = 44 * 32, IL = I0 + I1 + I2 + I3 + I4 + I5;
    for (int it = gw; it < NL * IL; it += NGW) {
        const int l = it / IL; int r = it % IL;
        if (r < I0) { transpose_item(a, 0, l, 1024, (bf16_t*)(ws + OFF_WIN) + (size_t)l * INC * 1024, scr, r, lane); continue; } r -= I0;
        if (r < I1) { transpose_item(a, 1, l, 512, (bf16_t*)(ws + OFF_WPROJ) + (size_t)l * 4096 * 512, scr, r, lane); continue; } r -= I1;
        if (r < I2) { transpose_item(a, 2, l, 1024, (bf16_t*)(ws + OFF_WOUT) + (size_t)l * 1024 * 1024, scr, r, lane); continue; } r -= I2;
        if (r < I3) { transpose_item(a, 3, l, 512, (bf16_t*)(ws + OFF_WGLU) + (size_t)l * 512 * 512, scr, r, lane); continue; } r -= I3;
        if (r < I4) { transpose_item(a, 4, l, 1024, (bf16_t*)(ws + OFF_WGU) + (size_t)l * 5632 * 1024, scr, r, lane); continue; } r -= I4;
        transpose_item(a, 5, l, FF, (bf16_t*)(ws + OFF_WDN) + (size_t)l * 1024 * FF, scr, r, lane);
    }
    {
        float* MODP = (float*)(ws + OFF_MODP);
        for (int it = gw; it < NL * 24 * 16; it += NGW) {
            const int l = it / (24 * 16), rem = it % (24 * 16), cb = rem >> 4, kc = rem & 15, col = cb * 256 + lane * 4;
            f32x4 s0 = {0, 0, 0, 0}, s1 = s0, s2 = s0, s3 = s0, s4 = s0;
            const float* wp = a.in[8] + ((size_t)l * 1024 + kc * 64) * 6144 + col;
#pragma unroll 8
            for (int k = 0; k < 64; ++k) { const f32x4 w = *(const f32x4*)(wp + (size_t)k * 6144); const int kk = kc * 64 + k;
                s0 += w * scond[kk]; s1 += w * scond[1024 + kk]; s2 += w * scond[2048 + kk]; s3 += w * scond[3072 + kk]; s4 += w * scond[4096 + kk]; }
            float* o = MODP + ((size_t)(kc * NL + l) * 5) * 6144 + col;
            *(f32x4*)o = s0; *(f32x4*)(o + 6144) = s1; *(f32x4*)(o + 2 * 6144) = s2; *(f32x4*)(o + 3 * 6144) = s3; *(f32x4*)(o + 4 * 6144) = s4;
        }
    }
    for (int idx = gw; idx < 256; idx += NGW) {
        const int p = lane;
        const double dtv = exp((double)a.in[22][idx]);
        const double lr = (double)a.in[16][idx * 64 + p], li = (double)a.in[17][idx * 64 + p];
        const double mag = exp(lr * dtv); double sn, cs; dsincos(li * dtv, sn, cs);
        const double ar = mag * cs, ai = mag * sn, den = lr * lr + li * li, nre = ar - 1.0;
        const double cre = (nre * lr + ai * li) / den, cim = (ai * lr - nre * li) / den;
        ((f32x2*)(ws + OFF_SSA))[idx * 64 + p] = (f32x2){(float)ar, (float)ai};
        for (int m = 1; m <= 17; ++m) { const double mm = m == 17 ? 256.0 : (double)m; const double mg = exp(mm * lr * dtv); double s2, c2; dsincos(mm * li * dtv, s2, c2);
            ((f32x2*)(ws + OFF_PW))[((size_t)idx * 17 + (m - 1)) * 64 + p] = (f32x2){(float)(mg * c2), (float)(mg * s2)}; }
        for (int k = 0; k < 16; ++k) { const double mg = exp(16.0 * k * lr * dtv); double s2, c2; dsincos(16.0 * k * li * dtv, s2, c2);
            ((f32x2*)(ws + OFF_PW16))[((size_t)idx * 16 + k) * 64 + p] = (f32x2){(float)(mg * c2), (float)(mg * s2)}; }
        bf16_t* WZF = (bf16_t*)(ws + OFF_BBF) + (size_t)idx * 8 * 512;
        f32x2* BBR = (f32x2*)(ws + OFF_BBR) + ((size_t)idx * 64 + p) * 16;
        const float* bre = a.in[18] + ((size_t)idx * 64 + p) * 16; const float* bim = a.in[19] + ((size_t)idx * 64 + p) * 16;
        const int fi = p >> 4, rw = p & 15, sdir = (idx >> 5) & 1;
#pragma unroll
        for (int hf = 0; hf < 2; ++hf) {
            float vr[8], vi[8], wr8[8], wi8[8];
#pragma unroll
            for (int e = 0; e < 8; ++e) { const double br = bre[8 * hf + e], bi = bim[8 * hf + e]; const double xr_ = cre * br - cim * bi, xi_ = cre * bi + cim * br;
                vr[e] = (float)xr_; vi[e] = (float)xi_; wr8[e] = (float)(ar * xr_ - ai * xi_); wi8[e] = (float)(ar * xi_ + ai * xr_); BBR[8 * hf + e] = (f32x2){vr[e], vi[e]}; }
            u32x4 br_, bi_, ar_, ai_;
            br_.x = cvt_pk_bf16(vr[0], vr[1]); br_.y = cvt_pk_bf16(vr[2], vr[3]); br_.z = cvt_pk_bf16(vr[4], vr[5]); br_.w = cvt_pk_bf16(vr[6], vr[7]);
            bi_.x = cvt_pk_bf16(vi[0], vi[1]); bi_.y = cvt_pk_bf16(vi[2], vi[3]); bi_.z = cvt_pk_bf16(vi[4], vi[5]); bi_.w = cvt_pk_bf16(vi[6], vi[7]);
            ar_.x = cvt_pk_bf16(wr8[0], wr8[1]); ar_.y = cvt_pk_bf16(wr8[2], wr8[3]); ar_.z = cvt_pk_bf16(wr8[4], wr8[5]); ar_.w = cvt_pk_bf16(wr8[6], wr8[7]);
            ai_.x = cvt_pk_bf16(wi8[0], wi8[1]); ai_.y = cvt_pk_bf16(wi8[2], wi8[3]); ai_.z = cvt_pk_bf16(wi8[4], wi8[5]); ai_.w = cvt_pk_bf16(wi8[6], wi8[7]);
            const int kg0 = hf, kg1 = 2 + hf;
            *(u32x4*)(WZF + ((fi * 2 + 0) * 64 + rw + 16 * kg0) * 8) = sdir ? br_ : ar_; *(u32x4*)(WZF + ((fi * 2 + 1) * 64 + rw + 16 * kg0) * 8) = sdir ? bi_ : ai_;
            *(u32x4*)(WZF + ((fi * 2 + 0) * 64 + rw + 16 * kg1) * 8) = sdir ? ar_ : br_; *(u32x4*)(WZF + ((fi * 2 + 1) * 64 + rw + 16 * kg1) * 8) = sdir ? ai_ : bi_;
        }
        bf16_t* CCF = (bf16_t*)(ws + OFF_CCF) + (size_t)idx * 4 * 512;
        const int kk = p >> 4, gq = (p >> 2) & 3, e = p & 3;
        for (int c = 0; c < 16; ++c) {
            const float crv = a.in[20][((size_t)idx * 16 + c) * 64 + p], civ = a.in[21][((size_t)idx * 16 + c) * 64 + p];
            bf16_t* q = CCF + (kk * 64 + c + 16 * gq) * 8;
            q[e] = (bf16_t)(cvt_pk_bf16(crv, 0.f) & 0xffffu); q[4 + e] = (bf16_t)(cvt_pk_bf16(-civ, 0.f) & 0xffffu);
        }
    }
    const int gt = blockIdx.x * 512 + opaque_tid(), NT = gridDim.x * 512;
    if (gt < 1024) { const int pos = gt >> 4, j = gt & 15; const double inv = exp(-(double)j * (9.210340371976184 / 16.0)); double sn, cs; dsincos((double)pos * inv, sn, cs);
        ((f32x2*)(ws + OFF_ROPE))[gt] = (f32x2){(float)cs, (float)sn}; }
    for (int i = gt; i < 4 * 4 * 256 * 256 / 4; i += NT) {
        const f32x4 k4 = ((const f32x4*)a.in[3])[i], v4 = ((const f32x4*)a.in[4])[i];
        ((u32x2*)(ws + OFF_KC))[i] = (u32x2){cvt_pk_bf16(k4[0], k4[1]), cvt_pk_bf16(k4[2], k4[3])};
        ((u32x2*)(ws + OFF_VC))[i] = (u32x2){cvt_pk_bf16(v4[0], v4[1]), cvt_pk_bf16(v4[2], v4[3])};
    }
}
__device__ __forceinline__ void p0_toeplitz(const KArgs& a, int gw, int NGW, int lane) {
    unsigned char* ws = a.ws;
    const int c = lane >> 2, cq = lane & 3;
    for (int it = gw; it < 256 * 16; it += NGW) {
        const int idx = it >> 4, dl = it & 15, sdir = (idx >> 5) & 1;
        const float* crp = a.in[20] + ((size_t)idx * 16 + c) * 64; const float* cip = a.in[21] + ((size_t)idx * 16 + c) * 64;
        const f32x2* pwp = (const f32x2*)(ws + OFF_PW) + ((size_t)idx * 17 + (dl > 0 ? dl - 1 : 0)) * 64;
        const f32x2* bbp = (const f32x2*)(ws + OFF_BBR) + (size_t)idx * 64 * 16 + 4 * cq;
        float k0 = 0.f, k1 = 0.f, k2 = 0.f, k3 = 0.f;
#pragma unroll 4
        for (int p = 0; p < 64; ++p) {
            const float cr = crp[p], ci = cip[p]; f32x2 pw = pwp[p]; if (dl == 0) pw = (f32x2){1.f, 0.f};
            const float wr_ = cr * pw[0] - ci * pw[1], wi_ = cr * pw[1] + ci * pw[0];
            const f32x4 b01 = *(const f32x4*)(bbp + p * 16), b23 = *(const f32x4*)(bbp + p * 16 + 2);
            k0 += wr_ * b01[0] - wi_ * b01[1]; k1 += wr_ * b01[2] - wi_ * b01[3]; k2 += wr_ * b23[0] - wi_ * b23[1]; k3 += wr_ * b23[2] - wi_ * b23[3];
        }
        const u32x2 kv = {cvt_pk_bf16(k0, k1), cvt_pk_bf16(k2, k3)}; const u32x2 zz = {0u, 0u};
        bf16_t* TF = (bf16_t*)(ws + OFF_TF) + (size_t)idx * 16 * 512;
        const int ea = sdir ? 1 : 0, eb = 1 - ea;
        *(u32x2*)(TF + (dl * 64 + c + 16 * (2 * ea + (cq >> 1))) * 8 + 4 * (cq & 1)) = kv;
        if (dl < 15) *(u32x2*)(TF + ((dl + 1) * 64 + c + 16 * (2 * eb + (cq >> 1))) * 8 + 4 * (cq & 1)) = kv;
        if (dl == 0) *(u32x2*)(TF + (c + 16 * (2 * eb + (cq >> 1))) * 8 + 4 * (cq & 1)) = zz;
    }
}
__device__ __forceinline__ void p0_mod_reduce(const KArgs& a) {
    const float* MODP = (const float*)(a.ws + OFF_MODP); float* MOD = (float*)(a.ws + OFF_MOD);
    const int gt = blockIdx.x * 512 + opaque_tid(), NT = gridDim.x * 512;
    for (int i = gt; i < NL * 5 * 6144; i += NT) {
        const int l = i / (5 * 6144), col = i % 6144;
        float s = a.in[9][l * 6144 + col];
#pragma unroll
        for (int kc = 0; kc < 16; ++kc) s += MODP[(size_t)kc * NL * 5 * 6144 + i];
        MOD[i] = s;
    }
}

__device__ __forceinline__ void norm_phase(const KArgs& a, int layer, bool first, const float* g, const float* modl, int shift_off, int scale_off, int gw, int NGW, int lane) {
    bf16_t* X = (bf16_t*)a.out; bf16_t* H = (bf16_t*)(a.ws + OFF_H);
    for (int row0 = gw; row0 < MROWS; row0 += 2 * NGW) {
        f32x4 v[2][4];
#pragma unroll
        for (int q = 0; q < 2; ++q) {
            const int row = row0 + q * NGW;
            if (first) {
                const float* xr = row < PROMPT_ROWS ? a.in[0] + (size_t)row * 1024 : a.in[1] + (size_t)(row - PROMPT_ROWS) * 1024;
#pragma unroll
                for (int j = 0; j < 2; ++j) { v[q][2 * j] = *(const f32x4*)(xr + 8 * lane + 512 * j); v[q][2 * j + 1] = *(const f32x4*)(xr + 8 * lane + 512 * j + 4); }
            } else {
#pragma unroll
                for (int j = 0; j < 2; ++j) { const u32x4 w = *(const u32x4*)(X + (size_t)row * XP + 8 * lane + 512 * j);
                    v[q][2 * j] = (f32x4){bflo(w.x), bfhi(w.x), bflo(w.y), bfhi(w.y)}; v[q][2 * j + 1] = (f32x4){bflo(w.z), bfhi(w.z), bflo(w.w), bfhi(w.w)}; }
            }
        }
#pragma unroll
        for (int q = 0; q < 2; ++q) {
            const int row = row0 + q * NGW;
            float ss = 0.f;
#pragma unroll
            for (int j = 0; j < 4; ++j) ss += v[q][j][0] * v[q][j][0] + v[q][j][1] * v[q][j][1] + v[q][j][2] * v[q][j][2] + v[q][j][3] * v[q][j][3];
            const float rstd = rsqrtf(wave_sum(ss) * (1.0f / 1024.0f) + RMS_EPS);
            const int cond = row < PROMPT_ROWS ? 0 : 1 + ((row - PROMPT_ROWS) >> 11);
            const float* sh = modl + cond * 6144 + shift_off; const float* sc = modl + cond * 6144 + scale_off;
#pragma unroll
            for (int j = 0; j < 2; ++j) {
                const int col = 8 * lane + 512 * j;
                const f32x4 oa = v[q][2 * j] * rstd * *(const f32x4*)(g + col) * (*(const f32x4*)(sc + col) + 1.0f) + *(const f32x4*)(sh + col);
                const f32x4 ob = v[q][2 * j + 1] * rstd * *(const f32x4*)(g + col + 4) * (*(const f32x4*)(sc + col + 4) + 1.0f) + *(const f32x4*)(sh + col + 4);
                *(u32x4*)(H + (size_t)row * 1024 + col) = pack8(oa, ob);
                if (first) *(u32x4*)(X + (size_t)row * XP + col) = pack8(v[q][2 * j], v[q][2 * j + 1]);
            }
        }
    }
}
__device__ __forceinline__ void final_norm_phase(const KArgs& a, int gw, int NGW, int lane) {
    float* Y = a.out; const bf16_t* X = (const bf16_t*)a.out; const float* g = a.in[34];
    for (int row = gw; row < MROWS; row += NGW) {
        f32x4 v[4]; float ss = 0.f;
#pragma unroll
        for (int j = 0; j < 2; ++j) { const u32x4 w = *(const u32x4*)(X + (size_t)row * XP + 8 * lane + 512 * j);
            v[2 * j] = (f32x4){bflo(w.x), bfhi(w.x), bflo(w.y), bfhi(w.y)}; v[2 * j + 1] = (f32x4){bflo(w.z), bfhi(w.z), bflo(w.w), bfhi(w.w)}; }
#pragma unroll
        for (int j = 0; j < 4; ++j) ss += v[j][0] * v[j][0] + v[j][1] * v[j][1] + v[j][2] * v[j][2] + v[j][3] * v[j][3];
        const float rstd = rsqrtf(wave_sum(ss) * (1.0f / 1024.0f) + RMS_EPS);
        asm volatile("s_waitcnt vmcnt(0)" ::: "memory");
#pragma unroll
        for (int j = 0; j < 2; ++j) { const int col = 8 * lane + 512 * j;
            *(f32x4*)(Y + (size_t)row * 1024 + col) = v[2 * j] * rstd * *(const f32x4*)(g + col); *(f32x4*)(Y + (size_t)row * 1024 + col + 4) = v[2 * j + 1] * rstd * *(const f32x4*)(g + col + 4); }
    }
}

template <int CTRL> __device__ __forceinline__ float dppf(float v) { return __builtin_bit_cast(float, __builtin_amdgcn_update_dpp(0, __builtin_bit_cast(int, v), CTRL, 0xf, 0xf, true)); }
template <int D, bool BWD, bool SQ> __device__ __forceinline__ void scan_step(f32x4 (&xr)[2], f32x4 (&xi)[2], f32x4 (&pr)[2], f32x4 (&pi)[2]) {
    constexpr int CTRL = BWD ? (0x100 + D) : (0x110 + D);
#pragma unroll
    for (int i = 0; i < 2; ++i)
#pragma unroll
        for (int j = 0; j < 4; ++j) {
            const float tr = dppf<CTRL>(xr[i][j]), ti = dppf<CTRL>(xi[i][j]);
            xr[i][j] += pr[i][j] * tr - pi[i][j] * ti; xi[i][j] += pr[i][j] * ti + pi[i][j] * tr;
            if (SQ) { const float a = pr[i][j], b = pi[i][j]; pr[i][j] = a * a - b * b; pi[i][j] = 2.f * a * b; }
        }
}
constexpr int SSM_DIRB = 28 * 1024, SSM_EOFF = 2 * SSM_DIRB;
__device__ __forceinline__ void cload4(const f32x2* p, f32x4& re, f32x4& im) { const f32x4 s0 = ((const f32x4*)p)[0], s1 = ((const f32x4*)p)[1]; re = (f32x4){s0[0], s0[2], s1[0], s1[2]}; im = (f32x4){s0[1], s0[3], s1[1], s1[3]}; }
template <bool BWD> __device__ __forceinline__ void ssm_in(const KArgs& a, const LAS unsigned char* lc, LAS float* E, const bf16x8 (&uf)[8], f32x4 (&hpr)[4], f32x4 (&hpi)[4],
                                                            int layer, bool sample, int seq, int seg, int g, int lane_in) {
    int lane = lane_in; asm volatile("" : "+v"(lane));
    constexpr int dir = BWD ? 1 : 0;
    unsigned char* ws = a.ws;
    const int n = lane & 15, gq = lane >> 4, idx = (layer * 2 + dir) * 32 + g;
    const LAS unsigned char* lf = lc + dir * SSM_DIRB + lane * 16;
    f32x4 a2r[4], a2i[4], sr[4], si[4];
#pragma unroll
    for (int i = 0; i < 4; ++i) { f32x4 ar, ai; cload4((const f32x2*)(ws + OFF_SSA) + idx * 64 + 16 * i + 4 * gq, ar, ai); a2r[i] = ar * ar - ai * ai; a2i[i] = 2.f * ar * ai; }
    const f32x4 z4 = {0.f, 0.f, 0.f, 0.f};
#pragma unroll
    for (int jj = 0; jj < 8; ++jj) {
        const int j = BWD ? 7 - jj : jj;
#pragma unroll
        for (int i = 0; i < 4; ++i) {
            f32x4 cr = z4, ci = z4;
            if (jj > 0) { cr = a2r[i] * sr[i] - a2i[i] * si[i]; ci = a2r[i] * si[i] + a2i[i] * sr[i]; }
            sr[i] = __builtin_amdgcn_mfma_f32_16x16x32_bf16(*(const LAS bf16x8*)(lf + (2 * i) * 1024), uf[j], cr, 0, 0, 0);
            si[i] = __builtin_amdgcn_mfma_f32_16x16x32_bf16(*(const LAS bf16x8*)(lf + (2 * i + 1) * 1024), uf[j], ci, 0, 0, 0);
        }
    }
#pragma unroll
    for (int hf = 0; hf < 2; ++hf) {
        f32x4 xr[2] = {sr[2 * hf], sr[2 * hf + 1]}, xi[2] = {si[2 * hf], si[2 * hf + 1]}, pr[2], pi[2];
        cload4((const f32x2*)(ws + OFF_PW) + ((size_t)idx * 17 + 15) * 64 + 16 * (2 * hf) + 4 * gq, pr[0], pi[0]);
        cload4((const f32x2*)(ws + OFF_PW) + ((size_t)idx * 17 + 15) * 64 + 16 * (2 * hf + 1) + 4 * gq, pr[1], pi[1]);
        scan_step<1, BWD, true>(xr, xi, pr, pi); scan_step<2, BWD, true>(xr, xi, pr, pi); scan_step<4, BWD, true>(xr, xi, pr, pi); scan_step<8, BWD, false>(xr, xi, pr, pi);
        sr[2 * hf] = xr[0]; sr[2 * hf + 1] = xr[1]; si[2 * hf] = xi[0]; si[2 * hf + 1] = xi[1];
    }
    if (n == (BWD ? 0 : 15)) {
        if (!sample) {
            const size_t so = ((size_t)((seq * 4 + layer) * 2 + dir) * 32 + g) * 64 + 4 * gq;
#pragma unroll
            for (int i = 0; i < 4; ++i) { *(f32x4*)(a.out + OUT_SR + so + 16 * i) = sr[i]; *(f32x4*)(a.out + OUT_SI + so + 16 * i) = si[i]; }
        } else {
            LAS float* e = E + ((dir * 8 + seg) * 64 + 4 * gq) * 2;
#pragma unroll
            for (int i = 0; i < 4; ++i) { *(LAS f32x4*)(e + 32 * i) = (f32x4){sr[i][0], si[i][0], sr[i][1], si[i][1]}; *(LAS f32x4*)(e + 32 * i + 4) = (f32x4){sr[i][2], si[i][2], sr[i][3], si[i][3]}; }
        }
    }
#pragma unroll
    for (int i = 0; i < 4; ++i)
#pragma unroll
        for (int j = 0; j < 4; ++j) { hpr[i][j] = dppf<BWD ? 0x101 : 0x111>(sr[i][j]); hpi[i][j] = dppf<BWD ? 0x101 : 0x111>(si[i][j]); }
}
template <bool BWD> __device__ __forceinline__ void ssm_out(const KArgs& a, const LAS unsigned char* lc, const LAS float* E, const bf16x8 (&uf)[8], f32x4 (&gr)[4], f32x4 (&gi)[4],
                                                             int layer, bool sample, int sq, int seg, int rowbase, int g, int lane_in) {
    int lane = lane_in; asm volatile("" : "+v"(lane));
    constexpr int dir = BWD ? 1 : 0;
    unsigned char* ws = a.ws;
    const int n = lane & 15, gq = lane >> 4, idx = (layer * 2 + dir) * 32 + g;
    const LAS unsigned char* lf = lc + dir * SSM_DIRB + lane * 16;
    const bf16_t* U = (const bf16_t*)(ws + OFF_U);
    float* YF = (float*)(ws + OFF_H); bf16_t* YG = (bf16_t*)(ws + OFF_YG);
    f32x4 are[4], aim[4];
#pragma unroll
    for (int i = 0; i < 4; ++i) {
        const int p0 = 16 * i + 4 * gq;
        cload4((const f32x2*)(ws + OFF_SSA) + idx * 64 + p0, are[i], aim[i]);
        if (sample) {
            f32x4 br, bi; cload4((const f32x2*)(ws + OFF_PW) + ((size_t)idx * 17 + 16) * 64 + p0, br, bi);
            const size_t so = ((size_t)((sq * 4 + layer) * 2 + dir) * 32 + g) * 64 + p0;
            f32x4 hr = *(const f32x4*)(a.in[5] + so), hi = *(const f32x4*)(a.in[6] + so);
            const int cnt = BWD ? 7 - seg : seg;
#pragma unroll 1
            for (int k = 0; k < cnt; ++k) {
                const int sidx = BWD ? 7 - k : k;
                f32x4 er, ei; { const LAS float* e = E + ((dir * 8 + sidx) * 64 + p0) * 2; const f32x4 e0 = *(const LAS f32x4*)e, e1 = *(const LAS f32x4*)(e + 4); er = (f32x4){e0[0], e0[2], e1[0], e1[2]}; ei = (f32x4){e0[1], e0[3], e1[1], e1[3]}; }
                const f32x4 t = br * hr - bi * hi + er; hi = br * hi + bi * hr + ei; hr = t;
            }
            f32x4 qr, qi; cload4((const f32x2*)(ws + OFF_PW16) + ((size_t)idx * 16 + (BWD ? 15 - n : n)) * 64 + p0, qr, qi);
            gr[i] += qr * hr - qi * hi; gi[i] += qr * hi + qi * hr;
        }
        { const f32x4 t = are[i] * gr[i] - aim[i] * gi[i]; gi[i] = are[i] * gi[i] + aim[i] * gr[i]; gr[i] = t; }
        __builtin_amdgcn_sched_barrier(0);
    }
    const f32x4 dvec = *(const f32x4*)(a.in[23] + layer * 512 + g * 16 + 4 * gq);
    const f32x4 z4 = {0.f, 0.f, 0.f, 0.f};
#pragma unroll
    for (int tt = 0; tt < 16; ++tt) {
        const int t = BWD ? 15 - tt : tt;
        const size_t tok = (size_t)rowbase + 16 * n + t;
        f32x4 y = z4;
#pragma unroll
        for (int i = 0; i < 4; ++i) {
            u32x4 w; w.x = cvt_pk_bf16(gr[i][0], gr[i][1]); w.y = cvt_pk_bf16(gr[i][2], gr[i][3]); w.z = cvt_pk_bf16(gi[i][0], gi[i][1]); w.w = cvt_pk_bf16(gi[i][2], gi[i][3]);
            y = __builtin_amdgcn_mfma_f32_16x16x32_bf16(*(const LAS bf16x8*)(lf + (24 + i) * 1024), __builtin_bit_cast(bf16x8, w), y, 0, 0, 0);
        }
        if (!BWD) {
#pragma unroll
            for (int j = 0; j < 8; ++j) if (2 * j <= t) y = __builtin_amdgcn_mfma_f32_16x16x32_bf16(*(const LAS bf16x8*)(lf + (8 + t - 2 * j) * 1024), uf[j], y, 0, 0, 0);
        } else {
#pragma unroll
            for (int j = 0; j < 8; ++j) if (2 * j + 1 >= t) y = __builtin_amdgcn_mfma_f32_16x16x32_bf16(*(const LAS bf16x8*)(lf + (8 + 2 * j + 1 - t) * 1024), uf[j], y, 0, 0, 0);
        }
        float* yfp = YF + tok * 512 + g * 16 + 4 * gq;
        if (!BWD) *(f32x4*)yfp = y;
        else {
            const f32x4 yf = *(const f32x4*)yfp; const u32x2 uw = *(const u32x2*)(U + tok * 512 + g * 16 + 4 * gq);
            f32x4 v = y + yf + dvec * (f32x4){bflo(uw.x), bfhi(uw.x), bflo(uw.y), bfhi(uw.y)};
#pragma unroll
            for (int j = 0; j < 4; ++j) { const float x = v[j]; const float z = 0.7978845608028654f * (x + 0.044715f * x * x * x); const float th = 1.0f - 2.0f * __builtin_amdgcn_rcpf(1.0f + __expf(2.0f * z)); v[j] = 0.5f * x * (1.0f + th); }
            *(u32x2*)(YG + tok * 512 + g * 16 + 4 * gq) = (u32x2){cvt_pk_bf16(v[0], v[1]), cvt_pk_bf16(v[2], v[3])};
        }
        if (tt < 15) {
#pragma unroll
            for (int i = 0; i < 4; ++i) { const f32x4 t_ = are[i] * gr[i] - aim[i] * gi[i]; gi[i] = are[i] * gi[i] + aim[i] * gr[i]; gr[i] = t_; }
        }
    }
}
__device__ __forceinline__ void ssm_phase(const KArgs& a, LAS unsigned char* lds, int layer, int wave, int lane) {
    unsigned char* ws = a.ws;
    LAS float* E = (LAS float*)(lds + SSM_EOFF);
    for (int bi = opaque_bid(); bi < 256; bi += gridDim.x) {
        const int g = bi & 31; const bool sample = bi < 128;
        const int sq = bi >> 5, seq = sample ? 0 : 8 * ((bi - 128) >> 5) + wave;
        const int rowbase = sample ? PROMPT_ROWS + sq * 2048 + wave * 256 : seq * 256;
        __syncthreads();
        for (int f = wave; f < 56; f += 8) {
            const int d = f / 28, ff = f % 28, idx = (layer * 2 + d) * 32 + g;
            const bf16_t* src = ff < 8 ? (const bf16_t*)(ws + OFF_BBF) + ((size_t)idx * 8 + ff) * 512 : ff < 24 ? (const bf16_t*)(ws + OFF_TF) + ((size_t)idx * 16 + ff - 8) * 512 : (const bf16_t*)(ws + OFF_CCF) + ((size_t)idx * 4 + ff - 24) * 512;
            *(LAS u32x4*)(lds + d * SSM_DIRB + ff * 1024 + lane * 16) = *(const u32x4*)(src + lane * 8);
        }
        bf16x8 uf[8];
        { const int n = lane & 15, gq = lane >> 4;
#pragma unroll
          for (int j = 0; j < 8; ++j) uf[j] = *(const bf16x8*)((const bf16_t*)(ws + OFF_U) + ((size_t)rowbase + 16 * n + 2 * j + (gq >> 1)) * 512 + g * 16 + 8 * (gq & 1)); }
        asm volatile("s_waitcnt vmcnt(0) lgkmcnt(0)" ::: "memory");
        __syncthreads();
        f32x4 hfr[4], hfi[4], hbr[4], hbi[4];
        ssm_in<false>(a, lds, E, uf, hfr, hfi, layer, sample, seq, wave, g, lane);
        ssm_in<true>(a, lds, E, uf, hbr, hbi, layer, sample, seq, wave, g, lane);
        asm volatile("s_waitcnt vmcnt(0) lgkmcnt(0)" ::: "memory");
        __syncthreads();
        ssm_out<false>(a, lds, E, uf, hfr, hfi, layer, sample, sq, wave, rowbase, g, lane);
        ssm_out<true>(a, lds, E, uf, hbr, hbi, layer, sample, sq, wave, rowbase, g, lane);
    }
}
__device__ __forceinline__ void conv_phase(const KArgs& a, int layer, int part, int nparts) {
    const int G = nparts;
    bf16_t* CB = (bf16_t*)(a.ws + OFF_CB); const bf16_t* P = (const bf16_t*)(a.ws + OFF_PCX);
    const float* cw = a.in[12] + layer * 3 * 512; const float* cbias = a.in[13] + layer * 512;
    const int gt = part * 512 + opaque_tid(), NT = G * 512;
    for (int i = gt; i < MROWS * 64; i += NT) {
        const int row = i >> 6, ch = (i & 63) * 8;
        const int t = row < PROMPT_ROWS ? (row & 255) : ((row - PROMPT_ROWS) & 2047), L = row < PROMPT_ROWS ? 256 : 2048;
        const u32x4 z = {0, 0, 0, 0};
        const u32x4 pc = *(const u32x4*)(P + (size_t)row * 512 + ch);
        const u32x4 pl = t > 0 ? *(const u32x4*)(P + (size_t)(row - 1) * 512 + ch) : z;
        const u32x4 pr = t < L - 1 ? *(const u32x4*)(P + (size_t)(row + 1) * 512 + ch) : z;
        const u32x4 cbv = *(const u32x4*)(CB + (size_t)row * 512 + ch);
        float o[8];
#pragma unroll
        for (int e = 0; e < 4; ++e) {
            const unsigned wl = e == 0 ? pl.x : e == 1 ? pl.y : e == 2 ? pl.z : pl.w, wc_ = e == 0 ? pc.x : e == 1 ? pc.y : e == 2 ? pc.z : pc.w, wr_ = e == 0 ? pr.x : e == 1 ? pr.y : e == 2 ? pr.z : pr.w, wb = e == 0 ? cbv.x : e == 1 ? cbv.y : e == 2 ? cbv.z : cbv.w;
            const int c0 = ch + 2 * e;
            o[2 * e] = bflo(wb) * (cw[c0] * bflo(wl) + cw[512 + c0] * bflo(wc_) + cw[1024 + c0] * bflo(wr_) + cbias[c0]);
            o[2 * e + 1] = bfhi(wb) * (cw[c0 + 1] * bfhi(wl) + cw[512 + c0 + 1] * bfhi(wc_) + cw[1024 + c0 + 1] * bfhi(wr_) + cbias[c0 + 1]);
        }
        u32x4 w; w.x = cvt_pk_bf16(o[0], o[1]); w.y = cvt_pk_bf16(o[2], o[3]); w.z = cvt_pk_bf16(o[4], o[5]); w.w = cvt_pk_bf16(o[6], o[7]);
        *(u32x4*)(CB + (size_t)row * 512 + ch) = w;
    }
}

constexpr int AT_KSTR = 144, AT_VSTR = 192, AT_VOFF = 64 * AT_KSTR, AT_BUF = AT_VOFF + 64 * AT_VSTR;
__device__ __forceinline__ s16x4 tr_read(const LAS unsigned char* p) { typedef short v4i16_t __attribute__((ext_vector_type(4))); return __builtin_bit_cast(s16x4, __builtin_amdgcn_ds_read_tr16_b64_v4i16((LAS v4i16_t*)p)); }
__device__ __forceinline__ void attn_unit(const KArgs& a, LAS unsigned char* lds, int layer, int unit) {
    unsigned char* ws = a.ws;
    const bf16_t* Q = (const bf16_t*)(ws + OFF_Q); const bf16_t* Kb = (const bf16_t*)(ws + OFF_K); const bf16_t* Vb = (const bf16_t*)(ws + OFF_V);
    bf16_t* YA = (bf16_t*)(ws + OFF_YA);
    int b, kvh, qb, rowbase, NTL, NT;
    if (unit < 256) { b = unit >> 6; kvh = (unit >> 4) & 3; qb = unit & 15; rowbase = PROMPT_ROWS + b * 2048; NTL = 32; NT = 36; }
    else { const int u2 = unit - 256; b = u2 >> 3; kvh = (u2 >> 1) & 3; qb = u2 & 1; rowbase = b * 256; NTL = 4; NT = 4; }
    int tid = threadIdx.x; asm volatile("" : "+v"(tid));
    const int lane = tid & 63, w = tid >> 6, r32 = lane & 31, hi = lane >> 5;
    const int hq = kvh * 4 + (w >> 1); const size_t qrow0 = (size_t)rowbase + qb * 128 + 32 * (w & 1) + r32;
    bf16x8 qr[2][4];
#pragma unroll
    for (int s_ = 0; s_ < 2; ++s_)
#pragma unroll
        for (int d0 = 0; d0 < 4; ++d0) qr[s_][d0] = *(const bf16x8*)(Q + (qrow0 + 64 * s_) * 1024 + hq * 64 + 16 * d0 + 8 * hi);
    const int lkey = tid >> 3, lch = tid & 7;
    const bf16_t* kc = (const bf16_t*)(ws + OFF_KC) + ((size_t)(b * 4 + layer) * 256) * 256; const bf16_t* vc = (const bf16_t*)(ws + OFF_VC) + ((size_t)(b * 4 + layer) * 256) * 256;
    u32x4 kreg, vreg;
#define AT_LOAD(t) do { const size_t _o = ((t) < NTL ? ((size_t)rowbase + (t) * 64 + lkey) : (size_t)(((t) - NTL) * 64 + lkey)) * 256 + kvh * 64 + lch * 8; \
        kreg = *(const u32x4*)(((t) < NTL ? Kb : kc) + _o); vreg = *(const u32x4*)(((t) < NTL ? Vb : vc) + _o); } while (0)
#define AT_STORE(buf) do { *(LAS u32x4*)(lds + (buf) * AT_BUF + lkey * AT_KSTR + lch * 16) = kreg; *(LAS u32x4*)(lds + (buf) * AT_BUF + AT_VOFF + lkey * AT_VSTR + lch * 16) = vreg; } while (0)
    AT_LOAD(0); AT_STORE(0);
    __syncthreads();
    f32x16 o0[2], o1[2];
#pragma unroll
    for (int r = 0; r < 16; ++r) { o0[0][r] = 0.f; o1[0][r] = 0.f; o0[1][r] = 0.f; o1[1][r] = 0.f; }
    float mrun[2] = {0.f, 0.f}, lrun[2] = {0.f, 0.f};
    const int vlane = ((lane & 15) >> 2) * AT_VSTR + (16 * ((lane >> 4) & 1) + 4 * (lane & 3)) * 2;
    for (int t = 0; t < NT; ++t) {
        if (t + 1 < NT) AT_LOAD(t + 1);
        const LAS unsigned char* Ks = lds + (t & 1) * AT_BUF; const LAS unsigned char* Vs = Ks + AT_VOFF;
        f32x16 p0[2], p1[2];
#pragma unroll
        for (int r = 0; r < 16; ++r) { p0[0][r] = -mrun[0]; p1[0][r] = -mrun[0]; p0[1][r] = -mrun[1]; p1[1][r] = -mrun[1]; }
#pragma unroll
        for (int d0 = 0; d0 < 4; ++d0) {
            const bf16x8 k0 = *(const LAS bf16x8*)(Ks + r32 * AT_KSTR + d0 * 32 + hi * 16);
            const bf16x8 k1 = *(const LAS bf16x8*)(Ks + (32 + r32) * AT_KSTR + d0 * 32 + hi * 16);
            p0[0] = __builtin_amdgcn_mfma_f32_32x32x16_bf16(k0, qr[0][d0], p0[0], 0, 0, 0);
            p1[0] = __builtin_amdgcn_mfma_f32_32x32x16_bf16(k1, qr[0][d0], p1[0], 0, 0, 0);
            p0[1] = __builtin_amdgcn_mfma_f32_32x32x16_bf16(k0, qr[1][d0], p0[1], 0, 0, 0);
            p1[1] = __builtin_amdgcn_mfma_f32_32x32x16_bf16(k1, qr[1][d0], p1[1], 0, 0, 0);
        }
        float tmax[2];
#pragma unroll
        for (int s_ = 0; s_ < 2; ++s_) {
            float m = p0[s_][0];
#pragma unroll
            for (int r = 0; r < 16; ++r) { m = fmaxf(m, p0[s_][r]); m = fmaxf(m, p1[s_][r]); }
            tmax[s_] = fmaxf(m, __shfl_xor(m, 32));
        }
        if (t == 0 || __builtin_amdgcn_ballot_w64(fmaxf(tmax[0], tmax[1]) > 8.0f) != 0ull) {
#pragma unroll
            for (int s_ = 0; s_ < 2; ++s_) {
                const float delta = t == 0 ? tmax[s_] : fmaxf(tmax[s_], 0.f), alpha = __builtin_amdgcn_exp2f(-delta);
                mrun[s_] += delta; lrun[s_] *= alpha;
#pragma unroll
                for (int r = 0; r < 16; ++r) { p0[s_][r] -= delta; p1[s_][r] -= delta; o0[s_][r] *= alpha; o1[s_][r] *= alpha; }
            }
        }
#pragma unroll
        for (int s_ = 0; s_ < 2; ++s_) {
            float psum = 0.f;
#pragma unroll
            for (int r = 0; r < 16; ++r) { p0[s_][r] = __builtin_amdgcn_exp2f(p0[s_][r]); p1[s_][r] = __builtin_amdgcn_exp2f(p1[s_][r]); psum += p0[s_][r] + p1[s_][r]; }
            lrun[s_] += psum;
        }
#pragma unroll
        for (int kh = 0; kh < 2; ++kh)
#pragma unroll
            for (int kk = 0; kk < 2; ++kk) {
                const LAS unsigned char* vb = Vs + (32 * kh + 16 * kk + 4 * hi) * AT_VSTR + vlane;
                const s16x4 a0 = tr_read(vb), a1 = tr_read(vb + 8 * AT_VSTR), c0 = tr_read(vb + 64), c1 = tr_read(vb + 8 * AT_VSTR + 64);
                const bf16x8 vf0 = {a0[0], a0[1], a0[2], a0[3], a1[0], a1[1], a1[2], a1[3]}, vf1 = {c0[0], c0[1], c0[2], c0[3], c1[0], c1[1], c1[2], c1[3]};
#pragma unroll
                for (int s_ = 0; s_ < 2; ++s_) {
                    u32x4 pw;
                    if (kh == 0) { pw.x = cvt_pk_bf16(p0[s_][8 * kk], p0[s_][8 * kk + 1]); pw.y = cvt_pk_bf16(p0[s_][8 * kk + 2], p0[s_][8 * kk + 3]); pw.z = cvt_pk_bf16(p0[s_][8 * kk + 4], p0[s_][8 * kk + 5]); pw.w = cvt_pk_bf16(p0[s_][8 * kk + 6], p0[s_][8 * kk + 7]); }
                    else { pw.x = cvt_pk_bf16(p1[s_][8 * kk], p1[s_][8 * kk + 1]); pw.y = cvt_pk_bf16(p1[s_][8 * kk + 2], p1[s_][8 * kk + 3]); pw.z = cvt_pk_bf16(p1[s_][8 * kk + 4], p1[s_][8 * kk + 5]); pw.w = cvt_pk_bf16(p1[s_][8 * kk + 6], p1[s_][8 * kk + 7]); }
                    const bf16x8 pf = __builtin_bit_cast(bf16x8, pw);
                    o0[s_] = __builtin_amdgcn_mfma_f32_32x32x16_bf16(vf0, pf, o0[s_], 0, 0, 0);
                    o1[s_] = __builtin_amdgcn_mfma_f32_32x32x16_bf16(vf1, pf, o1[s_], 0, 0, 0);
                }
            }
        if (t + 1 < NT) AT_STORE((t + 1) & 1);
        __syncthreads();
    }
#undef AT_LOAD
#undef AT_STORE
#pragma unroll
    for (int s_ = 0; s_ < 2; ++s_) {
        const float inv = __builtin_amdgcn_rcpf(lrun[s_] + __shfl_xor(lrun[s_], 32));
        bf16_t* op = YA + (size_t)(hq >> 3) * MROWS * 512 + (qrow0 + 64 * s_) * 512 + (hq & 7) * 64 + 4 * hi;
#pragma unroll
        for (int q4 = 0; q4 < 4; ++q4) {
            *(u32x2*)(op + 8 * q4) = (u32x2){cvt_pk_bf16(o0[s_][4 * q4] * inv, o0[s_][4 * q4 + 1] * inv), cvt_pk_bf16(o0[s_][4 * q4 + 2] * inv, o0[s_][4 * q4 + 3] * inv)};
            *(u32x2*)(op + 32 + 8 * q4) = (u32x2){cvt_pk_bf16(o1[s_][4 * q4] * inv, o1[s_][4 * q4 + 1] * inv), cvt_pk_bf16(o1[s_][4 * q4 + 2] * inv, o1[s_][4 * q4 + 3] * inv)};
        }
    }
}

#define XB_TMO      128
#define XB_XCNT(j)  (256  + 64 * (j))
#define XB_XSUB(j)  (1280 + 64 * (j))
#define XB_XGEN(j)  (2304 + 64 * (j))
#define XB_TOP      3328
#define XB_TOPGEN   3392
#define XCD_BAR_WORDS 3456
#define XB_SPIN_CAP (1u << 18)
__device__ __forceinline__ unsigned xb_ld(unsigned* p)              { return __hip_atomic_load(p, __ATOMIC_RELAXED, __HIP_MEMORY_SCOPE_AGENT); }
__device__ __forceinline__ unsigned xb_add(unsigned* p, unsigned v) { return __hip_atomic_fetch_add(p, v, __ATOMIC_RELAXED, __HIP_MEMORY_SCOPE_AGENT); }
__device__ __forceinline__ unsigned xb_xcc_id() { return (unsigned)__builtin_amdgcn_s_getreg((3 << 11) | 20) & 0xFu; }
#define XB_SPIN(cond, bar) do { unsigned _sp = 0; while (cond) { __builtin_amdgcn_s_sleep(1); \
    if ((++_sp & 255u) == 0u) { if (xb_ld(&(bar)[XB_TMO])) break; if (_sp > XB_SPIN_CAP) { atomicAdd(&(bar)[XB_TMO], 1u); break; } } } } while (0)
struct XcdBarrier { unsigned* bar; unsigned x; volatile LAS unsigned* st; };
__device__ __forceinline__ XcdBarrier xcd_barrier_post(unsigned* bar, volatile LAS unsigned* st) {
    XcdBarrier b; b.bar = bar; b.x = xb_xcc_id(); b.st = st;
    if (threadIdx.x == 0) (void)xb_add(&bar[XB_XCNT(b.x)], 1u);
    return b;
}
__device__ __forceinline__ void xcd_barrier_complete(unsigned* bar, unsigned x, unsigned& nloc, unsigned& nx) {
    const unsigned G = gridDim.x * gridDim.y * gridDim.z;
    unsigned sum, cnt, mine, sp = 0u;
    for (;;) {
        sum = 0u; cnt = 0u; mine = 0u;
#pragma unroll
        for (unsigned j = 0; j < 16; ++j) { const unsigned c = xb_ld(&bar[XB_XCNT(j)]); sum += c; cnt += (c > 0u) ? 1u : 0u; mine = (j == x) ? c : mine; }
        if (sum == G) break;
        __builtin_amdgcn_s_sleep(1);
        if ((++sp & 255u) == 0u) { if (xb_ld(&bar[XB_TMO])) break; if (sp > XB_SPIN_CAP) { atomicAdd(&bar[XB_TMO], 1u); break; } }
    }
    nloc = mine > 0u ? mine : 1u; nx = cnt > 0u ? cnt : 1u;
}
__device__ __forceinline__ void xcd_barrier(const XcdBarrier& b) {
    asm volatile("s_waitcnt vmcnt(0)" ::: "memory");
    __syncthreads();
    if (threadIdx.x == 0) {
        unsigned* bar = b.bar;
        __builtin_amdgcn_s_waitcnt(0);
        unsigned nloc = b.st[0], nx = b.st[1];
        if (nloc == 0u) { xcd_barrier_complete(bar, b.x, nloc, nx); b.st[0] = nloc; b.st[1] = nx; }
        const unsigned old = xb_add(&bar[XB_XSUB(b.x)], 1u);
        const unsigned gen = old / nloc;
        if (old + 1u == (gen + 1u) * nloc) {
            __builtin_amdgcn_fence(__ATOMIC_RELEASE, "agent");
            asm volatile("s_waitcnt vmcnt(0)" ::: "memory");
            const unsigned og = xb_add(&bar[XB_TOP], 1u);
            const unsigned tg = og / nx;
            if (og + 1u == (tg + 1u) * nx) xb_add(&bar[XB_TOPGEN], 1u);
            else XB_SPIN(xb_ld(&bar[XB_TOPGEN]) == tg, bar);
            __builtin_amdgcn_fence(__ATOMIC_ACQUIRE, "agent");
            xb_add(&bar[XB_XGEN(b.x)], 1u);
            asm volatile("s_waitcnt vmcnt(0)" ::: "memory");
        } else {
            XB_SPIN(xb_ld(&bar[XB_XGEN(b.x)]) == gen, bar);
            __builtin_amdgcn_fence(__ATOMIC_ACQUIRE, "agent");
            asm volatile("s_waitcnt vmcnt(0)" ::: "memory");
        }
    }
    __syncthreads();
}

#ifndef DUP
#define DUP 0
#endif
#define REP(bit) for (int rep_ = 0; rep_ < (((DUP) >> (bit)) & 1) + 1; ++rep_)
#define GSYNC() do { XcdBarrier xb_; xb_.bar = (unsigned*)(a.ws + OFF_CTL); xb_.x = xb_xcc_id(); xb_.st = (volatile LAS unsigned*)(lds + 131072 + 4096 - 16); xcd_barrier(xb_); if ((DUP) & 1) xcd_barrier(xb_); } while (0)
__global__ void __launch_bounds__(512, 2) fwd_megakernel(KArgs a) {
    extern __shared__ __attribute__((aligned(16))) unsigned char lds_raw[];
    LAS unsigned char* lds = (LAS unsigned char*)lds_raw;
    cg::grid_group grid = cg::this_grid();
    if (threadIdx.x < 4) ((volatile LAS unsigned*)(lds + 131072 + 4096 - 16))[threadIdx.x] = 0u;
    __syncthreads();
    (void)xcd_barrier_post((unsigned*)(a.ws + OFF_CTL), (volatile LAS unsigned*)(lds + 131072 + 4096 - 16));
    const int G = gridDim.x, NGW = G * 8;
    unsigned char* ws = a.ws;
    const float* MOD = (const float*)(ws + OFF_MOD);

    { const int tid0 = opaque_tid(), lane = tid0 & 63, wave = __builtin_amdgcn_readfirstlane(tid0 >> 6), gw = blockIdx.x * 8 + wave;
      REP(1) p0_prologue(a, lds, gw, NGW, wave, lane); }
    if (a.ws == nullptr) grid.sync();
    GSYNC();
    p0_mod_reduce(a);
    { const int tid0 = opaque_tid(), lane = tid0 & 63, wave = __builtin_amdgcn_readfirstlane(tid0 >> 6); p0_toeplitz(a, opaque_bid() * 8 + wave, NGW, lane); }
    GSYNC();

    for (int l = 0; l < NL; ++l) {
        const float* modl = MOD + (size_t)l * 5 * 6144;
        { const int t_ = opaque_tid(), lane = t_ & 63, wave = __builtin_amdgcn_readfirstlane(t_ >> 6); REP(6) norm_phase(a, l, l == 0, a.in[10] + l * 1024, modl, 0, 1024, opaque_bid() * 8 + wave, NGW, lane); }
        GSYNC();
        {
            pg8::SchedSimple S; S.init(ws + OFF_H, ws + OFF_WIN + (size_t)l * INC * 1024 * 2, MROWS, INC, 1024, G, opaque_bid());
            EpiIn E{(bf16_t*)(ws + OFF_CB), (bf16_t*)(ws + OFF_PCX), (bf16_t*)(ws + OFF_Q), (bf16_t*)(ws + OFF_K), (bf16_t*)(ws + OFF_V), (bf16_t*)(ws + OFF_U), (bf16_t*)(ws + OFF_G), a.out,
                    a.in[14] + l * 64, a.in[15] + l * 64, (const f32x2*)(ws + OFF_ROPE), l};
            REP(4) pg8::gemm_phase(lds, 1024, S, E);
        }
        GSYNC();
        { const int t_ = opaque_tid(), lane = t_ & 63, wave = __builtin_amdgcn_readfirstlane(t_ >> 6); REP(2) ssm_phase(a, lds, l, wave, lane); }
        GSYNC();
        REP(3) for (int u = opaque_bid(); u < 512; u += G) attn_unit(a, lds, l, u);
        {
            pg8::SchedSimple S; S.init(ws + OFF_YG, ws + OFF_WGLU + (size_t)l * 512 * 512 * 2, MROWS, 512, 512, G, opaque_bid());
            EpiGlu E{(const bf16_t*)(ws + OFF_YG), (bf16_t*)(ws + OFF_U), a.in[25] + l * 512};
            pg8::gemm_phase(lds, 512, S, E);
        }
        { const int bid = opaque_bid(); if (G >= 256) { if (bid >= 128) conv_phase(a, l, bid - 128, G - 128); } else conv_phase(a, l, bid, G); }
        GSYNC();
        {
            pg8::SchedProj S; S.o.init(MROWS, 1024, G, opaque_bid()); S.tstep = (size_t)256 * 512 * 2;
            S.A0 = (const char*)(ws + OFF_CB); S.A1 = (const char*)(ws + OFF_YA); S.A2 = (const char*)(ws + OFF_YA + (size_t)MROWS * 512 * 2); S.A3 = (const char*)(ws + OFF_U);
            S.B = (const char*)(ws + OFF_WPROJ + (size_t)l * 4096 * 512 * 2);
            EpiProj E{(const bf16_t*)(ws + OFF_G), (bf16_t*)(ws + OFF_Q)};
            REP(7) pg8::gemm_phase(lds, 512, S, E);
        }
        GSYNC();
        {
            pg8::SchedSimple S; S.init(ws + OFF_Q, ws + OFF_WOUT + (size_t)l * 1024 * 1024 * 2, MROWS, 1024, 1024, G, opaque_bid());
            EpiRes E{(bf16_t*)a.out, modl + 2048};
            pg8::gemm_phase(lds, 1024, S, E);
        }
        GSYNC();
        { const int t_ = opaque_tid(), lane = t_ & 63, wave = __builtin_amdgcn_readfirstlane(t_ >> 6); norm_phase(a, l, false, a.in[30] + l * 1024, modl, 3072, 4096, opaque_bid() * 8 + wave, NGW, lane); }
        GSYNC();
        {
            pg8::SchedSimple S; S.init(ws + OFF_H, ws + OFF_WGU + (size_t)l * 5632 * 1024 * 2, MROWS, 5632, 1024, G, opaque_bid());
            EpiFfn1 E{(bf16_t*)(ws + OFF_G)};
            REP(5) pg8::gemm_phase(lds, 1024, S, E);
        }
        GSYNC();
        {
            pg8::SchedSimple S; S.init(ws + OFF_G, ws + OFF_WDN + (size_t)l * 1024 * FF * 2, MROWS, 1024, FF, G, opaque_bid());
            EpiRes E{(bf16_t*)a.out, modl + 5120};
            pg8::gemm_phase(lds, FF, S, E);
        }
        GSYNC();
    }
    { const int tid0 = opaque_tid(), lane = tid0 & 63, wave = __builtin_amdgcn_readfirstlane(tid0 >> 6), gw = blockIdx.x * 8 + wave;
      final_norm_phase(a, gw, NGW, lane); }
}

extern "C" void kernel_launch(void* const* d_in, const int* in_sizes, int n_in, void* d_out, int out_size, void* d_ws, size_t ws_size, hipStream_t stream) {
    static int grid = 0;
    if (grid == 0) {
        if (n_in != 35 || ws_size < WS_END) { fprintf(stderr, "kernel_launch: n_in %d ws %zu (need %zu)\n", n_in, ws_size, (size_t)WS_END); grid = -1; return; }
        int dev = 0, cus = 0, per_cu = 0;
        hipGetDevice(&dev); hipDeviceGetAttribute(&cus, hipDeviceAttributeMultiprocessorCount, dev);
        hipFuncSetAttribute((const void*)fwd_megakernel, hipFuncAttributeMaxDynamicSharedMemorySize, LDS_BYTES);
        hipOccupancyMaxActiveBlocksPerMultiprocessor(&per_cu, (const void*)fwd_megakernel, 512, LDS_BYTES);
        if (per_cu < 1) { fprintf(stderr, "kernel_launch: occupancy %d\n", per_cu); per_cu = 1; }
        grid = cus;
        (void)hipGetLastError();
    }
    if (grid < 0) return;
    if (hipMemsetAsync((char*)d_ws + OFF_CTL, 0, 16384, stream) != hipSuccess) { fprintf(stderr, "kernel_launch: memset failed\n"); return; }
    KArgs a{};
    for (int i = 0; i < 35; ++i) a.in[i] = (const float*)d_in[i];
    a.out = (float*)d_out; a.ws = (unsigned char*)d_ws;
    void* args[] = {&a};
    hipError_t e = hipLaunchCooperativeKernel((const void*)fwd_megakernel, dim3(grid), dim3(512), args, LDS_BYTES, stream);
    if (e != hipSuccess) fprintf(stderr, "cooperative launch failed: %s (grid %d)\n", hipGetErrorString(e), grid);
}
```
